# Optimizing an MI355X kernel written in HIP

```python
import jax, jax.numpy as jnp
from jax import lax
import numpy as np

D_MODEL = 1024
BATCH = 8
SEQ = 4096
DEPTH = 2

BLOCK = 128
A_HEADS = 8
A_HEAD_DIM = 64
A_WIDTH = A_HEADS * A_HEAD_DIM
DILATED = ((128, 1), (512, 4), (2048, 16))
B_WIDTH = D_MODEL - A_WIDTH
SCONV_WIDTH = 3
IN_SPLITS = (A_WIDTH, A_WIDTH, A_WIDTH, B_WIDTH, B_WIDTH, B_WIDTH)
IN_WIDTH = sum(IN_SPLITS)
RET_HEADS = 4
RET_KDIM = D_MODEL // RET_HEADS
RET_VDIM = 2 * D_MODEL // RET_HEADS
RET_CHUNK = 128
ROPE_BASE = 10000.0
D_FF = 2816
FFN_CONV_WIDTH = 3
EPS = 1e-6
N_EVEN = (DEPTH + 1) // 2
N_ODD = DEPTH // 2

kernel_name = "hybrid_dilated_shortconv_retention_trunk"


def rms_norm(x, g):
    xf = x.astype(jnp.float32)
    y = xf * lax.rsqrt(jnp.mean(xf * xf, axis=-1, keepdims=True) + EPS)
    return (y * g.astype(jnp.float32)).astype(x.dtype)


def causal_dwconv(x, w):
    K = w.shape[0]
    S = x.shape[1]
    xp = jnp.pad(x, ((0, 0), (K - 1, 0), (0, 0)))
    y = xp[:, 0:S] * w[0]
    for j in range(1, K):
        y = y + xp[:, j:j + S] * w[j]
    return y


def banded_causal_attention(q, k, v, reach):
    L, hd = q.shape[-2], q.shape[-1]
    lead = q.shape[:-2]
    nb = -(-L // BLOCK)
    pad_end = nb * BLOCK - L
    zp = [(0, 0)] * len(lead)
    qb = jnp.pad(q, zp + [(0, pad_end), (0, 0)]).reshape(*lead, nb, BLOCK, hd)
    kp = jnp.pad(k, zp + [(BLOCK, pad_end), (0, 0)]).reshape(*lead, nb + 1, BLOCK, hd)
    vp = jnp.pad(v, zp + [(BLOCK, pad_end), (0, 0)]).reshape(*lead, nb + 1, BLOCK, hd)
    kb = jnp.concatenate([kp[..., :-1, :, :], kp[..., 1:, :, :]], axis=-2)
    vb = jnp.concatenate([vp[..., :-1, :, :], vp[..., 1:, :, :]], axis=-2)
    s = jnp.einsum('...nqd,...nkd->...nqk', qb.astype(jnp.float32), kb.astype(jnp.float32)) * (hd ** -0.5)
    blk = jnp.arange(nb)[:, None, None]
    qi = jnp.arange(BLOCK)[None, :, None]
    kj = jnp.arange(2 * BLOCK)[None, None, :]
    rel = BLOCK + qi - kj
    kpos = blk * BLOCK - BLOCK + kj
    mask = (rel >= 0) & (rel <= reach) & (kpos >= 0)
    s = jnp.where(mask, s, -jnp.inf)
    m = jnp.max(s, axis=-1, keepdims=True)
    p = jnp.exp(s - m)
    den = jnp.sum(p, axis=-1, keepdims=True)
    o = jnp.einsum('...nqk,...nkd->...nqd', p, vb.astype(jnp.float32)) / den
    lse = (m + jnp.log(den))[..., 0]
    o = o.reshape(*lead, nb * BLOCK, hd)[..., :L, :]
    lse = lse.reshape(*lead, nb * BLOCK)[..., :L]
    return o, lse


def dilated_attention(q, k, v):
    Bn, H, S, hd = q.shape
    outs, lses = [], []
    for window, dil in DILATED:
        L = S // dil
        split = lambda t: t.reshape(Bn, H, L, dil, hd).swapaxes(2, 3)
        o, lse = banded_causal_attention(split(q), split(k), split(v), window // dil)
        outs.append(o.swapaxes(2, 3).reshape(Bn, H, S, hd))
        lses.append(lse.swapaxes(2, 3).reshape(Bn, H, S))
    wts = jax.nn.softmax(jnp.stack(lses), axis=0)
    return jnp.sum(wts[..., None] * jnp.stack(outs), axis=0)


def even_mixer(xn, w_in, q_gain, k_gain, sconv_w, w_out):
    Bn, S, _ = xn.shape
    proj = xn @ w_in
    q, k, v, gate_b, gate_c, h = jnp.split(proj, np.cumsum(IN_SPLITS)[:-1].tolist(), axis=-1)
    heads = lambda t: t.reshape(Bn, S, A_HEADS, A_HEAD_DIM)
    q = rms_norm(heads(q), q_gain).transpose(0, 2, 1, 3)
    k = rms_norm(heads(k), k_gain).transpose(0, 2, 1, 3)
    v = heads(v).transpose(0, 2, 1, 3)
    a = dilated_attention(q, k, v).astype(xn.dtype).transpose(0, 2, 1, 3).reshape(Bn, S, A_WIDTH)
    b = gate_b * causal_dwconv(gate_c * h, sconv_w)
    return jnp.concatenate([a, b], axis=-1) @ w_out


def rotary(x, pos):
    half = x.shape[-1] // 2
    inv = ROPE_BASE ** (-jnp.arange(half, dtype=jnp.float32) / half)
    ang = pos[:, None] * inv[None, :]
    cos = jnp.cos(ang)[None, :, None, :]
    sin = jnp.sin(ang)[None, :, None, :]
    x1, x2 = x[..., :half], x[..., half:]
    return jnp.concatenate([x1 * cos - x2 * sin, x1 * sin + x2 * cos], axis=-1)


def chunkwise_retention(q, k, v):
    Bn, S, H, dk = q.shape
    dv = v.shape[-1]
    nc = S // RET_CHUNK
    log_g = jnp.log1p(-(2.0 ** (-5.0 - jnp.arange(H, dtype=jnp.float32))))
    i = jnp.arange(RET_CHUNK, dtype=jnp.float32)
    diff = i[:, None] - i[None, :]
    inner_decay = jnp.where(diff >= 0, jnp.exp(log_g[:, None, None] * jnp.maximum(diff, 0.0)), 0.0)
    q_decay = jnp.exp(log_g[:, None] * (i + 1.0))
    k_decay = jnp.exp(log_g[:, None] * (RET_CHUNK - 1.0 - i))
    chunk_decay = jnp.exp(log_g * RET_CHUNK)
    to_chunks = lambda t: t.reshape(Bn, nc, RET_CHUNK, H, t.shape[-1]).transpose(1, 0, 3, 2, 4)

    def step(state, qkv):
        qc, kc, vc = qkv
        scores = jnp.einsum('bhqd,bhkd->bhqk', qc, kc) * inner_decay
        o = (jnp.einsum('bhqk,bhke->bhqe', scores, vc)
             + jnp.einsum('bhqd,bhde->bhqe', qc, state) * q_decay[..., None])
        state = (state * chunk_decay[:, None, None]
                 + jnp.einsum('bhkd,bhke->bhde', kc * k_decay[..., None], vc))
        return state, o

    state0 = jnp.zeros((Bn, H, dk, dv), jnp.float32)
    _, o = lax.scan(step, state0, (to_chunks(q), to_chunks(k), to_chunks(v)))
    return o.transpose(1, 0, 3, 2, 4).reshape(Bn, S, H, dv)


def retention_mixer(xn, wq, wk, wv, wg, gn_gain, wo):
    Bn, S, _ = xn.shape
    pos = jnp.arange(S, dtype=jnp.float32)
    q = (xn @ wq).reshape(Bn, S, RET_HEADS, RET_KDIM).astype(jnp.float32)
    k = (xn @ wk).reshape(Bn, S, RET_HEADS, RET_KDIM).astype(jnp.float32) * (RET_KDIM ** -0.5)
    v = (xn @ wv).reshape(Bn, S, RET_HEADS, RET_VDIM).astype(jnp.float32)
    o = chunkwise_retention(rotary(q, pos), rotary(k, pos), v)
    mu = jnp.mean(o, axis=-1, keepdims=True)
    var = jnp.mean(jnp.square(o - mu), axis=-1, keepdims=True)
    o = (o - mu) * lax.rsqrt(var + EPS) * gn_gain.astype(jnp.float32)
    o = o.reshape(Bn, S, RET_HEADS * RET_VDIM).astype(xn.dtype)
    return (jax.nn.silu(xn @ wg) * o) @ wo


def conv_glu_ffn(xn, w_up, conv_w, w_down):
    u = causal_dwconv(xn @ w_up, conv_w)
    g, val = jnp.split(u, 2, axis=-1)
    return (jax.nn.silu(g) * val) @ w_down


def setup_inputs(seed: int = 0) -> dict:
    key = jax.random.key(seed)
    ks = jax.random.split(key, 24)
    nrm = lambda k, shape, s: jax.random.normal(k, shape, jnp.float32) * s
    gain = lambda k, shape: 1.0 + 0.02 * jax.random.normal(k, shape, jnp.float32)
    D = D_MODEL
    return {
        "x": jax.random.normal(ks[0], (BATCH, SEQ, D), jnp.float32),
        "even_norm": gain(ks[1], (N_EVEN, D)),
        "even_w_in": nrm(ks[2], (N_EVEN, D, IN_WIDTH), D ** -0.5),
        "even_q_gain": gain(ks[3], (N_EVEN, A_HEAD_DIM)),
        "even_k_gain": gain(ks[4], (N_EVEN, A_HEAD_DIM)),
        "even_sconv_w": nrm(ks[5], (N_EVEN, SCONV_WIDTH, B_WIDTH), SCONV_WIDTH ** -0.5),
        "even_w_out": nrm(ks[6], (N_EVEN, A_WIDTH + B_WIDTH, D), (A_WIDTH + B_WIDTH) ** -0.5),
        "odd_norm": gain(ks[7], (N_ODD, D)),
        "ret_wq": nrm(ks[8], (N_ODD, D, RET_HEADS * RET_KDIM), D ** -0.5),
        "ret_wk": nrm(ks[9], (N_ODD, D, RET_HEADS * RET_KDIM), D ** -0.5),
        "ret_wv": nrm(ks[10], (N_ODD, D, RET_HEADS * RET_VDIM), D ** -0.5),
        "ret_wg": nrm(ks[11], (N_ODD, D, RET_HEADS * RET_VDIM), D ** -0.5),
        "ret_gn_gain": gain(ks[12], (N_ODD, RET_HEADS, RET_VDIM)),
        "ret_wo": nrm(ks[13], (N_ODD, RET_HEADS * RET_VDIM, D), (RET_HEADS * RET_VDIM) ** -0.5),
        "ffn_norm": gain(ks[14], (DEPTH, D)),
        "ffn_w_up": nrm(ks[15], (DEPTH, D, 2 * D_FF), D ** -0.5),
        "ffn_conv_w": nrm(ks[16], (DEPTH, FFN_CONV_WIDTH, 2 * D_FF), FFN_CONV_WIDTH ** -0.5),
        "ffn_w_down": nrm(ks[17], (DEPTH, D_FF, D), D_FF ** -0.5),
    }


def reference(x, even_norm, even_w_in, even_q_gain, even_k_gain, even_sconv_w, even_w_out,
              odd_norm, ret_wq, ret_wk, ret_wv, ret_wg, ret_gn_gain, ret_wo,
              ffn_norm, ffn_w_up, ffn_conv_w, ffn_w_down):
    for l in range(DEPTH):
        if l % 2 == 0:
            e = l // 2
            x = x + even_mixer(rms_norm(x, even_norm[e]), even_w_in[e], even_q_gain[e],
                               even_k_gain[e], even_sconv_w[e], even_w_out[e])
        else:
            o = l // 2
            x = x + retention_mixer(rms_norm(x, odd_norm[o]), ret_wq[o], ret_wk[o], ret_wv[o],
                                    ret_wg[o], ret_gn_gain[o], ret_wo[o])
        x = x + conv_glu_ffn(rms_norm(x, ffn_norm[l]), ffn_w_up[l], ffn_conv_w[l], ffn_w_down[l])
    return x
```

```cpp
#include <hip/hip_runtime.h>
#include <hip/hip_cooperative_groups.h>
#include <cstdio>
#include <cstdint>

constexpr int M_TOK = 32768, SEQ = 4096, DM = 1024;
constexpr int DFF = 2816, NUP = 2 * DFF;
constexpr float EPS = 1e-6f;
constexpr float LOG2E = 1.4426950408889634f;
constexpr float QSCALE = 0.125f * LOG2E;

#define LAS __attribute__((address_space(3)))
__device__ __forceinline__ int tidx_opaque() { int t_ = threadIdx.x; asm volatile("" : "+v"(t_)); return t_ & 511; }
#define TIDX() tidx_opaque()
#define GAS __attribute__((address_space(1)))

namespace pg8 {
#define PG8_LAS __attribute__((address_space(3)))
typedef unsigned short bf16_t;
typedef short bf16x8 __attribute__((ext_vector_type(8)));
typedef float f32x4 __attribute__((ext_vector_type(4)));
typedef unsigned u32x4 __attribute__((ext_vector_type(4)));
typedef unsigned u32x2 __attribute__((ext_vector_type(2)));
constexpr int BM = 256, BK = 64, HALF = 128, HTB = HALF * BK * 2  , STAGE_BYTES = 8 * HTB, NXCD = 8, WGM = 8;

__host__ __device__ __forceinline__ int lds_byte(int r, int c) { const int st = (r >> 4) * 2 + (c >> 5), rr = r & 15, cc = c & 31, ob = rr * 64 + cc * 2; return st * 1024 + (ob ^ (((ob >> 9) & 1) << 5)); }
__host__ __device__ __forceinline__ void stage_rc(int b, int& R, int& C) { const int st = b / 1024, sb = b % 1024, swz = sb ^ (((sb >> 9) & 1) << 5); R = (st >> 1) * 16 + swz / 64; C = (st & 1) * 32 + (swz % 64) / 2; }
__host__ __device__ __forceinline__ int perm32(int rho) { const int n = rho >> 4, i = rho & 15; return 8 * (i >> 2) + 4 * n + (i & 3); }

struct Unit { int pm, pn; };
struct Gemm { const bf16_t* A; const bf16_t* Bt; int M, N, K; };

struct StaticOrder {
    int nM, nN, nwg, G, c;
    __host__ __device__ __forceinline__ void init(int M, int N, int G_, int c_) { nM = M / BM; nN = N / BM; nwg = nM * nN; G = G_; c = c_; }
    __host__ __device__ __forceinline__ bool next(int i, Unit& u) const {
        const long L = (long)i * G + c; if (L >= nwg) return false;
        int wgid = (int)L; { const int q = nwg / NXCD, r = nwg % NXCD, xcd = wgid % NXCD, off = wgid / NXCD; wgid = (xcd < r ? xcd * (q + 1) : r * (q + 1) + (xcd - r) * q) + off; }
        const int nig = WGM * nN, gid = wgid / nig, fm = gid * WGM, gsz = (nM - fm) < WGM ? (nM - fm) : WGM;
        u.pm = fm + ((wgid % nig) % gsz); u.pn = (wgid % nig) / gsz; return true;
    }
    __device__ __forceinline__ void a_ready(const Unit&) const {}
    __device__ __forceinline__ void done(const Unit&) const {}
};

constexpr int MH = 16384;
__device__ __forceinline__ void ev_early_acquire(const unsigned* done_word, volatile LAS unsigned* flag, unsigned tag) {
    if (done_word == nullptr) return;
    const int t = TIDX();
    if (__builtin_amdgcn_readfirstlane(t >> 6) == 1) {
        unsigned d;
        asm volatile("s_load_dword %0, %1, 0x0 glc\n\ts_waitcnt lgkmcnt(0)" : "=s"(d) : "s"(done_word) : "memory");
        if (d != 0u) { asm volatile("buffer_inv sc1" ::: "memory"); if (t == 64) *flag = tag; }
    }
}
struct HalfOrder {
    StaticOrder so; int pm_off; const unsigned* e_word; volatile LAS unsigned* e_flag; unsigned e_tag;
    __device__ __forceinline__ void init(int N, int G, int c, int half) { so.init(MH, N, G, half ? G - 1 - c : c); pm_off = half * (MH / BM); e_word = nullptr; e_flag = nullptr; e_tag = 0u; }
    __device__ __forceinline__ void set_early(const unsigned* w, volatile LAS unsigned* f, unsigned tag) { e_word = w; e_flag = f; e_tag = tag; }
    __device__ __forceinline__ void early() const { ev_early_acquire(e_word, e_flag, e_tag); }
    __device__ __forceinline__ bool next(int i, Unit& u) const { if (!so.next(i, u)) return false; u.pm += pm_off; return true; }
    __device__ __forceinline__ void a_ready(const Unit&, int) const {}
    __device__ __forceinline__ void done(const Unit&, int) const {}
    __device__ __forceinline__ size_t a_off(const Unit&) const { return 0; }
};

typedef float f32x2_t __attribute__((ext_vector_type(2))); typedef __bf16 bf16x2_t __attribute__((ext_vector_type(2)));
__device__ __forceinline__ unsigned cvt_pk_bf16(float lo, float hi) { f32x2_t v = {lo, hi}; bf16x2_t b = __builtin_convertvector(v, bf16x2_t); return __builtin_bit_cast(unsigned, b); }
__device__ __forceinline__ float bflo(unsigned w) { return __uint_as_float(w << 16); }
__device__ __forceinline__ float bfhi(unsigned w) { return __uint_as_float(w & 0xffff0000u); }
__device__ __forceinline__ float xor16_32_sum(float s) { s += __shfl_xor(s, 16); s += __shfl_xor(s, 32); return s; }
__device__ __forceinline__ float silu_f(float x) { return x * __builtin_amdgcn_rcpf(1.0f + __builtin_amdgcn_exp2f(-x * LOG2E)); }

constexpr int XO_RS = 2048, XO_CW = 4096, XO_GN = 5632;
#define EPI_BAR() do { asm volatile("s_waitcnt lgkmcnt(0)" ::: "memory"); __builtin_amdgcn_s_barrier(); asm volatile("" ::: "memory"); } while (0)
__device__ __forceinline__ void rs_prefetch(const float* ssq, const Unit& u, LAS float* xch, int ui) {
    const int wid = __builtin_amdgcn_readfirstlane(TIDX() >> 6), lane = TIDX() & 63;
    if (wid < 4) __builtin_amdgcn_global_load_lds((const unsigned*)(ssq + (size_t)(u.pm * BM + 64 * wid + lane) * 4), (LAS unsigned*)(xch + XO_RS + (ui & 1) * 1024 + 64 * wid * 4), 16, 0, 0);
}
__device__ __forceinline__ float rs_row(const LAS float* xch, int ui, int row) {
    const f32x4 a = *(const LAS f32x4*)(xch + XO_RS + (ui & 1) * 1024 + row * 4);
    return __builtin_amdgcn_rsqf(((a[0] + a[1]) + (a[2] + a[3])) * (1.0f / 1024.0f) + EPS);
}
__device__ __forceinline__ void rs_read(const LAS float* xch, int ui, int wr, int fr, float (&rs)[2][4]) {
#pragma unroll
    for (int ai = 0; ai < 2; ++ai)
#pragma unroll
        for (int m = 0; m < 4; ++m) rs[ai][m] = rs_row(xch, ui, ai * HALF + wr * 64 + m * 16 + fr);
}

struct EpiProj {
    static constexpr bool PERM = true, AFTER_DRAIN = false, AROWPERM = false, FUSED_INIT = false; static constexpr int NSTORE = 16;
    struct Init {};
    __device__ __forceinline__ void init_load(Init&, const Unit&, int, int, int, int) const {}
    __device__ __forceinline__ void init_acc(const Init&, f32x4 (&acc)[2][2][4][2]) const {
#pragma unroll
        for (int a = 0; a < 2; ++a)
#pragma unroll
            for (int b = 0; b < 2; ++b)
#pragma unroll
                for (int m = 0; m < 4; ++m)
#pragma unroll
                    for (int n = 0; n < 2; ++n) acc[a][b][m][n] = (f32x4){0.f, 0.f, 0.f, 0.f};
    }
    bf16_t* out; size_t hd; const float* ssq; const float* qg; const float* kg; LAS float* xch;
    __device__ __forceinline__ void prefetch(const Unit& u, int ui) const {
        rs_prefetch(ssq, u, xch, ui);
        const int wid = __builtin_amdgcn_readfirstlane(TIDX() >> 6), lane = TIDX() & 63;
        if (wid == 4) __builtin_amdgcn_global_load_lds((const unsigned*)(qg + lane), (LAS unsigned*)(xch + XO_GN), 4, 0, 0);
        if (wid == 5) __builtin_amdgcn_global_load_lds((const unsigned*)(kg + lane), (LAS unsigned*)(xch + XO_GN + 64), 4, 0, 0);
    }
    __device__ __forceinline__ void operator()(const f32x4 (&acc)[2][2][4][2], const Unit& u, int wr, int wc, int fr, int fq, int ui) const {
        asm volatile("" : "+v"(fr), "+v"(fq));
        const int row0 = u.pm * BM + wr * 64 + fr;
        float rs[2][4]; rs_read(xch, ui, wr, fr, rs);
        const int t = u.pn >> 1, cbase = (u.pn & 1) * 256 + wc * 64 + 8 * fq;
        bf16_t* const outh = out + ((u.pm >= MH / BM) ? hd : (size_t)0);
        bf16_t* base = outh + (size_t)t * ((size_t)MH * 512);
        if (t < 2) {
            const LAS float* gn = xch + XO_GN + (t == 0 ? 0 : 64); const float sc = (t == 0) ? QSCALE : 1.0f;
            f32x4 gv[2][2];
#pragma unroll
            for (int bj = 0; bj < 2; ++bj)
#pragma unroll
                for (int n = 0; n < 2; ++n) gv[bj][n] = *(const LAS f32x4*)(gn + 32 * bj + 8 * fq + 4 * n);
#pragma unroll
            for (int ai = 0; ai < 2; ++ai)
#pragma unroll
                for (int m = 0; m < 4; ++m) {
                    f32x4 v[2][2]; float ss = 0.f;
#pragma unroll
                    for (int bj = 0; bj < 2; ++bj)
#pragma unroll
                        for (int n = 0; n < 2; ++n) { v[bj][n] = acc[ai][bj][m][n] * rs[ai][m]; const f32x4 x = v[bj][n]; ss += (x[0] * x[0] + x[1] * x[1]) + (x[2] * x[2] + x[3] * x[3]); }
                    ss = xor16_32_sum(ss);
                    const float r = __builtin_amdgcn_rsqf(ss * (1.0f / 64.0f) + EPS) * sc;
                    bf16_t* rowp = base + (size_t)(row0 + ai * HALF + m * 16) * 512 + cbase;
#pragma unroll
                    for (int bj = 0; bj < 2; ++bj) { const f32x4 a = v[bj][0] * gv[bj][0] * r, b = v[bj][1] * gv[bj][1] * r;
                        u32x4 w; w.x = cvt_pk_bf16(a[0], a[1]); w.y = cvt_pk_bf16(a[2], a[3]); w.z = cvt_pk_bf16(b[0], b[1]); w.w = cvt_pk_bf16(b[2], b[3]);
                        *(u32x4*)(rowp + 32 * bj) = w; }
                }
        } else if (u.pn >= 8) {
            bf16_t* pb = outh + (size_t)4 * ((size_t)MH * 512) + (u.pn - 8) * 128 + wc * 32 + 8 * fq;
#pragma unroll
            for (int ai = 0; ai < 2; ++ai)
#pragma unroll
                for (int m = 0; m < 4; ++m) { const float r2 = rs[ai][m] * rs[ai][m];
                    const f32x4 a = acc[ai][0][m][0] * acc[ai][1][m][0] * r2, b = acc[ai][0][m][1] * acc[ai][1][m][1] * r2;
                    u32x4 w; w.x = cvt_pk_bf16(a[0], a[1]); w.y = cvt_pk_bf16(a[2], a[3]); w.z = cvt_pk_bf16(b[0], b[1]); w.w = cvt_pk_bf16(b[2], b[3]);
                    *(u32x4*)(pb + (size_t)(row0 + ai * HALF + m * 16) * 512) = w; }
        } else {
#pragma unroll
            for (int ai = 0; ai < 2; ++ai)
#pragma unroll
                for (int m = 0; m < 4; ++m) {
                    bf16_t* rowp = base + (size_t)(row0 + ai * HALF + m * 16) * 512 + cbase;
#pragma unroll
                    for (int bj = 0; bj < 2; ++bj) { const f32x4 a = acc[ai][bj][m][0] * rs[ai][m], b = acc[ai][bj][m][1] * rs[ai][m];
                        u32x4 w; w.x = cvt_pk_bf16(a[0], a[1]); w.y = cvt_pk_bf16(a[2], a[3]); w.z = cvt_pk_bf16(b[0], b[1]); w.w = cvt_pk_bf16(b[2], b[3]);
                        *(u32x4*)(rowp + 32 * bj) = w; }
                }
        }
    }
};

template <bool LAST> struct EpiRes {
    static constexpr bool PERM = true, AFTER_DRAIN = false, AROWPERM = false, FUSED_INIT = true; static constexpr int NSTORE = 16;
    float* out; bf16_t* xb; float* ssq; LAS float* xch;
    __device__ __forceinline__ void prefetch(const Unit&, int) const {}
    struct Init { u32x4 rv[2][4][2]; };
    __device__ __forceinline__ void init_load(Init& I, const Unit& u, int wr, int wc, int fr, int fq) const {
        const bf16_t* p = xb + (size_t)(u.pm * BM + wr * 64 + fr) * DM + u.pn * BM + wc * 32 + 8 * fq;
#pragma unroll
        for (int ai = 0; ai < 2; ++ai)
#pragma unroll
            for (int m = 0; m < 4; ++m)
#pragma unroll
                for (int bj = 0; bj < 2; ++bj) I.rv[ai][m][bj] = *(const u32x4*)(p + (size_t)(ai * HALF + m * 16) * DM + bj * HALF);
    }
    __device__ __forceinline__ void init_acc(const Init& I, f32x4 (&acc)[2][2][4][2]) const {
#pragma unroll
        for (int ai = 0; ai < 2; ++ai)
#pragma unroll
            for (int m = 0; m < 4; ++m)
#pragma unroll
                for (int bj = 0; bj < 2; ++bj) { const u32x4 r = I.rv[ai][m][bj];
                    acc[ai][bj][m][0] = (f32x4){bflo(r.x), bfhi(r.x), bflo(r.y), bfhi(r.y)}; acc[ai][bj][m][1] = (f32x4){bflo(r.z), bfhi(r.z), bflo(r.w), bfhi(r.w)}; }
    }
    __device__ __forceinline__ void fused(f32x4 (&acc)[2][2][4][2], const Unit& u, const Unit& un, bool has_next, int wr, int wc, int fr, int fq, int) const {
        asm volatile("" : "+v"(fr), "+v"(fq));
        const int row0 = u.pm * BM + wr * 64 + fr, col0 = u.pn * BM + wc * 32 + 8 * fq;
        const bf16_t* pn = xb + (size_t)(un.pm * BM + wr * 64 + fr) * DM + un.pn * BM + wc * 32 + 8 * fq;
#pragma unroll
        for (int ai = 0; ai < 2; ++ai) {
            u32x4 rv[4][2];
            if (has_next) {
#pragma unroll
                for (int m = 0; m < 4; ++m)
#pragma unroll
                    for (int bj = 0; bj < 2; ++bj) rv[m][bj] = *(const u32x4*)(pn + (size_t)(ai * HALF + m * 16) * DM + bj * HALF);
            }
            asm volatile("" ::: "memory");
#pragma unroll
            for (int m = 0; m < 4; ++m) {
                const int row = row0 + ai * HALF + m * 16; const size_t off = (size_t)row * DM + col0; float s = 0.f;
#pragma unroll
                for (int bj = 0; bj < 2; ++bj) {
                    const f32x4 o0 = acc[ai][bj][m][0], o1 = acc[ai][bj][m][1];
                    if (LAST) { *(f32x4*)(out + off + bj * HALF) = o0; *(f32x4*)(out + off + bj * HALF + 4) = o1; }
                    else { u32x4 w; w.x = cvt_pk_bf16(o0[0], o0[1]); w.y = cvt_pk_bf16(o0[2], o0[3]); w.z = cvt_pk_bf16(o1[0], o1[1]); w.w = cvt_pk_bf16(o1[2], o1[3]);
                        *(u32x4*)(xb + off + bj * HALF) = w;
                        const float r0 = bflo(w.x), r1 = bfhi(w.x), r2 = bflo(w.y), r3 = bfhi(w.y), r4 = bflo(w.z), r5 = bfhi(w.z), r6 = bflo(w.w), r7 = bfhi(w.w);
                        s += ((r0 * r0 + r1 * r1) + (r2 * r2 + r3 * r3)) + ((r4 * r4 + r5 * r5) + (r6 * r6 + r7 * r7)); }
                }
                if (!LAST) { s = xor16_32_sum(s); if (fq == 0) xch[(ai * HALF + wr * 64 + m * 16 + fr) * 4 + wc] = s; }
            }
            asm volatile("" ::: "memory");
            if (has_next) {
#pragma unroll
                for (int m = 0; m < 4; ++m)
#pragma unroll
                    for (int bj = 0; bj < 2; ++bj) { const u32x4 r = rv[m][bj];
                        acc[ai][bj][m][0] = (f32x4){bflo(r.x), bfhi(r.x), bflo(r.y), bfhi(r.y)}; acc[ai][bj][m][1] = (f32x4){bflo(r.z), bfhi(r.z), bflo(r.w), bfhi(r.w)}; }
            }
        }
        if (!LAST) {
            EPI_BAR();
            const int t = TIDX();
            if (t < 256) { const f32x4 v = *(const LAS f32x4*)(xch + t * 4); ssq[(size_t)(u.pm * BM + t) * 4 + u.pn] = (v[0] + v[1]) + (v[2] + v[3]); }
        }
    }
};

__device__ __forceinline__ float dpp_shr1(float old, float src) { return __builtin_bit_cast(float, __builtin_amdgcn_update_dpp(__builtin_bit_cast(int, old), __builtin_bit_cast(int, src), 0x111, 0xF, 0xF, false)); }

struct EpiUp {
    static constexpr bool PERM = true, AFTER_DRAIN = false, AROWPERM = true, FUSED_INIT = false; static constexpr int NSTORE = 16;
    struct Init {};
    __device__ __forceinline__ void init_load(Init&, const Unit&, int, int, int, int) const {}
    __device__ __forceinline__ void init_acc(const Init&, f32x4 (&acc)[2][2][4][2]) const {
#pragma unroll
        for (int a = 0; a < 2; ++a)
#pragma unroll
            for (int b = 0; b < 2; ++b)
#pragma unroll
                for (int m = 0; m < 4; ++m)
#pragma unroll
                    for (int n = 0; n < 2; ++n) acc[a][b][m][n] = (f32x4){0.f, 0.f, 0.f, 0.f};
    }
    bf16_t* hid; size_t hd; const float* ssq; const float* cw; float* uf; float* ul; LAS float* xch;
    __device__ __forceinline__ void prefetch(const Unit& u, int ui) const {
        rs_prefetch(ssq, u, xch, ui);
        const int wid = __builtin_amdgcn_readfirstlane(TIDX() >> 6), lane = TIDX() & 63;
        if (wid >= 4 && wid < 7) { const int k = wid - 4, col = lane * 4, bj = col >> 7, i = col & 127;
            __builtin_amdgcn_global_load_lds((const unsigned*)(cw + (size_t)k * NUP + bj * DFF + u.pn * 128 + i), (LAS unsigned*)(xch + XO_CW + (ui & 1) * 768 + k * 256), 16, 0, 0); }
    }
    __device__ __forceinline__ void operator()(const f32x4 (&acc)[2][2][4][2], const Unit& u, int wr, int wc, int fr, int fq, int ui) const {
        asm volatile("" : "+v"(fr), "+v"(fq));
        const int row0 = u.pm * BM + wr * 64 + 4 * fr;
        bf16_t* const hidh = hid + ((u.pm >= MH / BM) ? hd : (size_t)0);
        const LAS float* cwl = xch + XO_CW + (ui & 1) * 768;
        float rs[2][4];
#pragma unroll
        for (int ai = 0; ai < 2; ++ai)
#pragma unroll
            for (int m = 0; m < 4; ++m) rs[ai][m] = rs_row(xch, ui, ai * HALF + wr * 64 + 4 * fr + m);
        const int colw = 32 * wc + 8 * fq;
        if (fr == 15) {
#pragma unroll
            for (int ai = 0; ai < 2; ++ai)
#pragma unroll
                for (int e = 0; e < 2; ++e)
#pragma unroll
                    for (int bj = 0; bj < 2; ++bj)
#pragma unroll
                        for (int n = 0; n < 2; ++n) {
                            const f32x4 v = acc[ai][bj][2 + e][n] * rs[ai][2 + e];
                            *(LAS f32x4*)(xch + ((2 * ai + wr) * 2 + e) * 256 + 128 * bj + colw + 4 * n) = v;
                            if (ai == 1 && wr == 1) *(f32x4*)(ul + ((size_t)u.pm * 2 + e) * NUP + u.pn * 256 + 128 * bj + colw + 4 * n) = v;
                        }
        }
        if (fr == 0 && wr == 0) {
#pragma unroll
            for (int e = 0; e < 2; ++e)
#pragma unroll
                for (int bj = 0; bj < 2; ++bj)
#pragma unroll
                    for (int n = 0; n < 2; ++n)
                        *(f32x4*)(uf + ((size_t)u.pm * 2 + e) * NUP + u.pn * 256 + 128 * bj + colw + 4 * n) = acc[0][bj][e][n] * rs[0][e];
        }
        EPI_BAR();
        const int ch0 = u.pn * 128 + colw;
#pragma unroll
        for (int n = 0; n < 2; ++n) {
            f32x4 wg[3], wv[3];
#pragma unroll
            for (int k = 0; k < 3; ++k) { wg[k] = *(const LAS f32x4*)(cwl + k * 256 + colw + 4 * n); wv[k] = *(const LAS f32x4*)(cwl + k * 256 + 128 + colw + 4 * n); }
#pragma unroll
            for (int ai = 0; ai < 2; ++ai) {
                asm volatile("" ::: "memory");
                const int q = 2 * ai + wr;
                f32x4 e1g, e2g, e1v, e2v;
                if (q == 0) { e1g = (f32x4){0.f, 0.f, 0.f, 0.f}; e2g = e1g; e1v = e1g; e2v = e1g; }
                else { const LAS float* e = xch + ((q - 1) * 2) * 256 + colw + 4 * n; e2g = *(const LAS f32x4*)e; e2v = *(const LAS f32x4*)(e + 128); e1g = *(const LAS f32x4*)(e + 256); e1v = *(const LAS f32x4*)(e + 384); }
                f32x4 cg[4], cv[4], h[4];
#pragma unroll
                for (int m = 0; m < 4; ++m) { cg[m] = acc[ai][0][m][n] * rs[ai][m]; cv[m] = acc[ai][1][m][n] * rs[ai][m]; }
#pragma unroll
                for (int j = 0; j < 4; ++j) {
                    const float g3 = dpp_shr1(e1g[j], cg[3][j]), g2 = dpp_shr1(e2g[j], cg[2][j]);
                    const float v3 = dpp_shr1(e1v[j], cv[3][j]), v2 = dpp_shr1(e2v[j], cv[2][j]);
                    const float yg0 = wg[2][j] * cg[0][j] + wg[1][j] * g3 + wg[0][j] * g2,       yv0 = wv[2][j] * cv[0][j] + wv[1][j] * v3 + wv[0][j] * v2;
                    const float yg1 = wg[2][j] * cg[1][j] + wg[1][j] * cg[0][j] + wg[0][j] * g3, yv1 = wv[2][j] * cv[1][j] + wv[1][j] * cv[0][j] + wv[0][j] * v3;
                    const float yg2 = wg[2][j] * cg[2][j] + wg[1][j] * cg[1][j] + wg[0][j] * cg[0][j], yv2 = wv[2][j] * cv[2][j] + wv[1][j] * cv[1][j] + wv[0][j] * cv[0][j];
                    const float yg3 = wg[2][j] * cg[3][j] + wg[1][j] * cg[2][j] + wg[0][j] * cg[1][j], yv3 = wv[2][j] * cv[3][j] + wv[1][j] * cv[2][j] + wv[0][j] * cv[1][j];
                    h[0][j] = silu_f(yg0) * yv0; h[1][j] = silu_f(yg1) * yv1; h[2][j] = silu_f(yg2) * yv2; h[3][j] = silu_f(yg3) * yv3;
                }
#pragma unroll
                for (int m = 0; m < 4; ++m) { u32x2 w; w.x = cvt_pk_bf16(h[m][0], h[m][1]); w.y = cvt_pk_bf16(h[m][2], h[m][3]);
                    *(u32x2*)(hidh + (size_t)(row0 + ai * HALF + m) * DFF + ch0 + 4 * n) = w; }
            }
        }
    }
};

struct EpiQKV {
    static constexpr bool PERM = true, AFTER_DRAIN = false, AROWPERM = false, FUSED_INIT = false; static constexpr int NSTORE = 16;
    struct Init {};
    __device__ __forceinline__ void init_load(Init&, const Unit&, int, int, int, int) const {}
    __device__ __forceinline__ void init_acc(const Init&, f32x4 (&acc)[2][2][4][2]) const {
#pragma unroll
        for (int a = 0; a < 2; ++a)
#pragma unroll
            for (int b = 0; b < 2; ++b)
#pragma unroll
                for (int m = 0; m < 4; ++m)
#pragma unroll
                    for (int n = 0; n < 2; ++n) acc[a][b][m][n] = (f32x4){0.f, 0.f, 0.f, 0.f};
    }
    bf16_t* q; bf16_t* k; bf16_t* v; size_t hdq, hdv; const float* ssq; const float* cosT; const float* sinT; LAS float* xch;
    __device__ __forceinline__ void prefetch(const Unit& u, int ui) const { rs_prefetch(ssq, u, xch, ui); }
    __device__ __forceinline__ void operator()(const f32x4 (&acc)[2][2][4][2], const Unit& u, int wr, int wc, int fr, int fq, int ui) const {
        asm volatile("" : "+v"(fr), "+v"(fq));
        const int row0 = u.pm * BM + wr * 64 + fr;
        float rs[2][4]; rs_read(xch, ui, wr, fr, rs);
        const int i0 = 32 * wc + 8 * fq;
        if (u.pn < 8) {
            bf16_t* base = ((u.pn < 4) ? q : k) + ((u.pm >= MH / BM) ? hdq : (size_t)0); const int head = u.pn & 3;
#pragma unroll
            for (int ai = 0; ai < 2; ++ai)
#pragma unroll
                for (int mp = 0; mp < 2; ++mp) {
                    f32x4 tc[2][2], ts[2][2];
#pragma unroll
                    for (int mm = 0; mm < 2; ++mm) { const int pos = (row0 + ai * HALF + (2 * mp + mm) * 16) & (SEQ - 1);
#pragma unroll
                        for (int n = 0; n < 2; ++n) { tc[mm][n] = *(const f32x4*)(cosT + (size_t)pos * 128 + i0 + 4 * n); ts[mm][n] = *(const f32x4*)(sinT + (size_t)pos * 128 + i0 + 4 * n); } }
                    asm volatile("" ::: "memory");
#pragma unroll
                    for (int mm = 0; mm < 2; ++mm) { const int m = 2 * mp + mm; const int row = row0 + ai * HALF + m * 16; const float r = rs[ai][m];
                        bf16_t* rowp = base + (size_t)row * 1024 + head * 256 + i0;
                        u32x4 w1, w2;
#pragma unroll
                        for (int n = 0; n < 2; ++n) {
                            const f32x4 x1 = acc[ai][0][m][n] * r, x2 = acc[ai][1][m][n] * r;
                            const f32x4 o1 = x1 * tc[mm][n] - x2 * ts[mm][n], o2 = x1 * ts[mm][n] + x2 * tc[mm][n];
                            if (n == 0) { w1.x = cvt_pk_bf16(o1[0], o1[1]); w1.y = cvt_pk_bf16(o1[2], o1[3]); w2.x = cvt_pk_bf16(o2[0], o2[1]); w2.y = cvt_pk_bf16(o2[2], o2[3]); }
                            else        { w1.z = cvt_pk_bf16(o1[0], o1[1]); w1.w = cvt_pk_bf16(o1[2], o1[3]); w2.z = cvt_pk_bf16(o2[0], o2[1]); w2.w = cvt_pk_bf16(o2[2], o2[3]); }
                        }
                        *(u32x4*)rowp = w1; *(u32x4*)(rowp + 128) = w2; }
                    asm volatile("" ::: "memory");
                }
        } else {
            const int c0 = (u.pn - 8) * 256 + i0;
#pragma unroll
            for (int ai = 0; ai < 2; ++ai)
#pragma unroll
                for (int m = 0; m < 4; ++m) {
                    bf16_t* rowp = v + ((u.pm >= MH / BM) ? hdv : (size_t)0) + (size_t)(row0 + ai * HALF + m * 16) * 2048 + c0;
#pragma unroll
                    for (int bj = 0; bj < 2; ++bj) { const f32x4 a = acc[ai][bj][m][0] * rs[ai][m], b = acc[ai][bj][m][1] * rs[ai][m];
                        u32x4 w; w.x = cvt_pk_bf16(a[0], a[1]); w.y = cvt_pk_bf16(a[2], a[3]); w.z = cvt_pk_bf16(b[0], b[1]); w.w = cvt_pk_bf16(b[2], b[3]);
                        *(u32x4*)(rowp + 128 * bj) = w; }
                }
        }
    }
};

struct EpiGate {
    static constexpr bool PERM = true, AFTER_DRAIN = false, AROWPERM = false, FUSED_INIT = false; static constexpr int NSTORE = 16;
    struct Init {};
    __device__ __forceinline__ void init_load(Init&, const Unit&, int, int, int, int) const {}
    __device__ __forceinline__ void init_acc(const Init&, f32x4 (&acc)[2][2][4][2]) const {
#pragma unroll
        for (int a = 0; a < 2; ++a)
#pragma unroll
            for (int b = 0; b < 2; ++b)
#pragma unroll
                for (int m = 0; m < 4; ++m)
#pragma unroll
                    for (int n = 0; n < 2; ++n) acc[a][b][m][n] = (f32x4){0.f, 0.f, 0.f, 0.f};
    }
    bf16_t* ro; const float* ssq; const float* mr; const float* gng; LAS float* xch;
    __device__ __forceinline__ void prefetch(const Unit& u, int ui) const {
        rs_prefetch(ssq, u, xch, ui);
        const int wid = __builtin_amdgcn_readfirstlane(TIDX() >> 6), lane = TIDX() & 63;
        if (wid == 4 || wid == 5)
            __builtin_amdgcn_global_load_lds((const unsigned*)(mr + ((size_t)(u.pn >> 1) * M_TOK + u.pm * BM + 128 * (wid - 4) + 2 * lane) * 2), (LAS unsigned*)(xch + (ui & 1) * 512 + 256 * (wid - 4)), 16, 0, 0);
    }
    __device__ __forceinline__ void operator()(const f32x4 (&acc)[2][2][4][2], const Unit& u, int wr, int wc, int fr, int fq, int ui) const {
        asm volatile("" : "+v"(fr), "+v"(fq));
        const int row0 = u.pm * BM + wr * 64 + fr;
        float rs[2][4]; rs_read(xch, ui, wr, fr, rs);
        const int c0 = u.pn * 256 + 32 * wc + 8 * fq;
        const LAS float* mrl = xch + (ui & 1) * 512;
        f32x4 gg[2][2];
#pragma unroll
        for (int bj = 0; bj < 2; ++bj)
#pragma unroll
            for (int n = 0; n < 2; ++n) gg[bj][n] = *(const f32x4*)(gng + c0 + 128 * bj + 4 * n);
#pragma unroll
        for (int ai = 0; ai < 2; ++ai) {
            u32x4 ov[4][2];
#pragma unroll
            for (int m = 0; m < 4; ++m)
#pragma unroll
                for (int bj = 0; bj < 2; ++bj) ov[m][bj] = *(const u32x4*)(ro + (size_t)(row0 + ai * HALF + m * 16) * 2048 + c0 + 128 * bj);
            asm volatile("" ::: "memory");
#pragma unroll
            for (int m = 0; m < 4; ++m) {
                const int rl = ai * HALF + wr * 64 + m * 16 + fr;
                const float mu = mrl[2 * rl], rg = mrl[2 * rl + 1];
                bf16_t* rowp = ro + (size_t)(row0 + ai * HALF + m * 16) * 2048 + c0;
#pragma unroll
                for (int bj = 0; bj < 2; ++bj) {
                    const u32x4 o4 = ov[m][bj];
                    const f32x4 g0 = acc[ai][bj][m][0] * rs[ai][m], g1 = acc[ai][bj][m][1] * rs[ai][m];
                    float o[8] = {bflo(o4.x), bfhi(o4.x), bflo(o4.y), bfhi(o4.y), bflo(o4.z), bfhi(o4.z), bflo(o4.w), bfhi(o4.w)};
                    float r[8];
#pragma unroll
                    for (int j = 0; j < 4; ++j) { r[j] = silu_f(g0[j]) * (o[j] - mu) * rg * gg[bj][0][j]; r[4 + j] = silu_f(g1[j]) * (o[4 + j] - mu) * rg * gg[bj][1][j]; }
                    u32x4 w; w.x = cvt_pk_bf16(r[0], r[1]); w.y = cvt_pk_bf16(r[2], r[3]); w.z = cvt_pk_bf16(r[4], r[5]); w.w = cvt_pk_bf16(r[6], r[7]);
                    *(u32x4*)(rowp + 128 * bj) = w;
                }
            }
            asm volatile("" ::: "memory");
        }
    }
};

template <class Epi, class Sched, bool ALIGN_EPI = false, bool SP2 = false>
__device__ __forceinline__ void gemm_phase(PG8_LAS unsigned char* lds, const Gemm g, const Sched& S, const Epi& E) {
    static_assert(Epi::NSTORE >= 16, "the relaxed waits below assume >= 16 epilogue stores per wave");
    const int tid = TIDX(), wid = __builtin_amdgcn_readfirstlane(tid >> 6), lane = tid & 63, wr = wid >> 2, wc = wid & 3, fr = lane & 15, fq = lane >> 4;
    const int K = g.K, nt = K / BK;
    unsigned voffA[2], voffB[2];
#pragma unroll
    for (int i = 0; i < 2; ++i) { int R, C; stage_rc(tid * 16 + i * 8192, R, C); const int Rb = Epi::PERM ? ((R & ~31) + perm32(R & 31)) : R;
        const int Ra = Epi::AROWPERM ? ((R & ~63) | ((R & 15) << 2) | ((R >> 4) & 3)) : R;
        voffA[i] = (unsigned)(Ra * K + C) * 2u; voffB[i] = (unsigned)(Rb * K + C) * 2u; }
    const size_t kstep = (size_t)(BK * 2);
    const size_t hstep = (size_t)HALF * K * 2;
    const size_t tstep = 2 * hstep;
    const unsigned ldsw = (unsigned)wid * 1024u;
    const int aoff = lds_byte(wr * 64 + fr, fq * 8), boff = lds_byte(wc * 32 + fr, fq * 8);
#define PG8_SA(b, h) (((b) * 2 + (h)) * HTB)
#define PG8_SB(b, h) ((4 + (b) * 2 + (h)) * HTB)
#define PG8_STAGE(bufoff, gbase, voff) do { _Pragma("unroll") for (int _i = 0; _i < 2; ++_i) \
        __builtin_amdgcn_global_load_lds((const unsigned*)((const char*)(gbase) + (voff)[_i]), (PG8_LAS unsigned*)(lds + (bufoff) + ldsw + _i * 8192), 16, 0, 0); } while (0)
#define PG8_LDA(dst, b, h) do { _Pragma("unroll") for (int m = 0; m < 4; ++m) _Pragma("unroll") for (int k = 0; k < 2; ++k) dst[m][k] = *(const PG8_LAS bf16x8*)(lds + PG8_SA(b, h) + aoff + m * 2048 + k * 1024); } while (0)
#define PG8_LDB(dst, b, h) do { _Pragma("unroll") for (int n = 0; n < 2; ++n) _Pragma("unroll") for (int k = 0; k < 2; ++k) dst[n][k] = *(const PG8_LAS bf16x8*)(lds + PG8_SB(b, h) + boff + n * 2048 + k * 1024); } while (0)
#define PG8_MMA(ai, bj, At, Bt) do { __builtin_amdgcn_s_setprio(1); _Pragma("unroll") for (int m = 0; m < 4; ++m) _Pragma("unroll") for (int n = 0; n < 2; ++n) _Pragma("unroll") for (int k = 0; k < 2; ++k) \
        acc[ai][bj][m][n] = __builtin_amdgcn_mfma_f32_16x16x32_bf16(Bt[n][k], At[m][k], acc[ai][bj][m][n], 0, 0, 0); __builtin_amdgcn_s_setprio(0); } while (0)
#define PG8_LAUNDER asm volatile("" : "+v"(voffA[0]), "+v"(voffA[1]), "+v"(voffB[0]), "+v"(voffB[1]))
#define PG8_WAIT_V_(n) asm volatile("s_waitcnt vmcnt(" #n ")" ::: "memory")
#define PG8_WAIT_V(n) PG8_WAIT_V_(n)
#define PG8_WAIT_L(n) asm volatile("s_waitcnt lgkmcnt(" #n ")" ::: "memory")
#define PG8_BAR __builtin_amdgcn_s_barrier()
#define PG8_SCHED __builtin_amdgcn_sched_barrier(0)
    Unit cur, nxt; int ui = 0;
    if (!S.next(0, cur)) return;
    f32x4 acc[2][2][4][2];
    bf16x8 At[4][2], B0[2][2], B1[2][2];
    const char* cA = (const char*)g.A + (size_t)cur.pm * tstep + S.a_off(cur); const char* cB = (const char*)g.Bt + (size_t)cur.pn * tstep;
    S.a_ready(cur, 0);
    typename Epi::Init ini0; E.init_load(ini0, cur, wr, wc, fr, fq);
    if constexpr (SP2) {
        PG8_LAUNDER; PG8_STAGE(PG8_SB(0, 0), cB, voffB); PG8_LAUNDER; PG8_STAGE(PG8_SB(0, 1), cB + hstep, voffB); PG8_LAUNDER; PG8_STAGE(PG8_SA(0, 0), cA, voffA); PG8_LAUNDER; PG8_STAGE(PG8_SA(0, 1), cA + hstep, voffA);
        if (wr == 1) PG8_BAR;
        PG8_WAIT_V(2); PG8_BAR;
        PG8_LAUNDER; PG8_STAGE(PG8_SB(1, 0), cB + kstep, voffB); PG8_LAUNDER; PG8_STAGE(PG8_SA(1, 0), cA + kstep, voffA); PG8_LAUNDER; PG8_STAGE(PG8_SB(1, 1), cB + hstep + kstep, voffB);
        PG8_WAIT_V(6); PG8_BAR;
    } else {
        PG8_STAGE(PG8_SB(0, 0), cB, voffB); PG8_STAGE(PG8_SA(0, 0), cA, voffA); PG8_STAGE(PG8_SB(0, 1), cB + hstep, voffB); PG8_STAGE(PG8_SA(0, 1), cA + hstep, voffA);
        if (wr == 1) PG8_BAR;
        PG8_WAIT_V(4); PG8_BAR;
        PG8_STAGE(PG8_SB(1, 0), cB + kstep, voffB); PG8_STAGE(PG8_SA(1, 0), cA + kstep, voffA); PG8_STAGE(PG8_SB(1, 1), cB + hstep + kstep, voffB);
        PG8_WAIT_V(6); PG8_BAR;
    }
    PG8_SCHED;
    E.init_acc(ini0, acc);
    for (;;) {
        E.prefetch(cur, ui);
        const bool has_next = S.next(ui + 1, nxt);
        const char* nA = has_next ? (const char*)g.A + (size_t)nxt.pm * tstep + S.a_off(nxt) : cA; const char* nB = has_next ? (const char*)g.Bt + (size_t)nxt.pn * tstep : cB;
#define PG8_TRIP(TV) do { \
            const char* a1 = cA + (size_t)(t + 1) * kstep; \
            const char* a2 = last ? nA : cA + (size_t)(t + 2) * kstep; const char* b2 = last ? nB : cB + (size_t)(t + 2) * kstep; \
            const char* a3 = a2 + kstep; const char* b3 = b2 + kstep; \
            if (last && has_next) S.a_ready(nxt, ui + 1); \
            PG8_LDB(B0, 0, 0); PG8_LDB(B1, 0, 1); PG8_SCHED; PG8_LDA(At, 0, 0); PG8_STAGE(PG8_SA(1, 1), a1 + hstep, voffA); \
            PG8_WAIT_V(8); PG8_WAIT_L(0); PG8_BAR; PG8_MMA(0, 0, At, B0); PG8_MMA(0, 1, At, B1); PG8_BAR; PG8_SCHED; \
            PG8_LDA(At, 0, 1); PG8_STAGE(PG8_SB(0, 0), b2, voffB); PG8_STAGE(PG8_SB(0, 1), b2 + hstep, voffB); PG8_STAGE(PG8_SA(0, 0), a2, voffA); \
            PG8_WAIT_V(8); PG8_WAIT_L(0); PG8_BAR; PG8_MMA(1, 0, At, B0); PG8_MMA(1, 1, At, B1); PG8_BAR; PG8_SCHED; \
            PG8_LDB(B0, 1, 0); PG8_LDB(B1, 1, 1); PG8_SCHED; PG8_LDA(At, 1, 0); PG8_STAGE(PG8_SA(0, 1), a2 + hstep, voffA); \
            PG8_WAIT_V(8); PG8_WAIT_L(0); PG8_BAR; PG8_MMA(0, 0, At, B0); PG8_MMA(0, 1, At, B1); PG8_BAR; PG8_SCHED; \
            PG8_LDA(At, 1, 1); PG8_STAGE(PG8_SB(1, 0), b3, voffB); PG8_STAGE(PG8_SB(1, 1), b3 + hstep, voffB); PG8_STAGE(PG8_SA(1, 0), a3, voffA); \
            PG8_WAIT_V(8); PG8_WAIT_L(0); PG8_BAR; PG8_MMA(1, 0, At, B0); PG8_MMA(1, 1, At, B1); PG8_BAR; PG8_SCHED; \
        } while (0)
        static_assert(SP2, "only the SP2 form of the K-loop is kept in this file");
        for (int t = 0; t < nt; t += 2) { const bool last = (t == nt - 2); PG8_TRIP(t); }
#undef PG8_TRIP
        if constexpr (ALIGN_EPI) { if (wr == 0) PG8_BAR; }
        if (!has_next) S.early();

        if constexpr (Epi::FUSED_INIT) { E.fused(acc, cur, nxt, has_next, wr, wc, fr, fq, ui); S.done(cur, ui); if (!has_next) break; }
        else { E(acc, cur, wr, wc, fr, fq, ui); S.done(cur, ui); if (!has_next) break; typename Epi::Init ini; E.init_load(ini, nxt, wr, wc, fr, fq); E.init_acc(ini, acc); }
        cur = nxt; cA = nA; cB = nB; ++ui;
        if constexpr (ALIGN_EPI) { if (wr == 1) PG8_BAR; }
    }
    PG8_WAIT_V(0);
    if constexpr (!ALIGN_EPI) { if (wr == 0) PG8_BAR; }
    PG8_BAR;
    if constexpr (Epi::AFTER_DRAIN) { E.fused(acc, cur, wr, wc, fr, fq, lds, wid, lane); S.done(cur, ui); }
#undef PG8_SA
#undef PG8_SB
#undef PG8_STAGE
#undef PG8_LDA
#undef PG8_LDB
#undef PG8_MMA
#undef PG8_LAUNDER
#undef PG8_WAIT_V
#undef PG8_WAIT_V_
#undef PG8_WAIT_L
#undef PG8_BAR
#undef PG8_SCHED
}
}

typedef unsigned short bf16;
typedef short bf16x8 __attribute__((ext_vector_type(8)));
typedef float f32x4 __attribute__((ext_vector_type(4)));
typedef unsigned u32x4 __attribute__((ext_vector_type(4)));
typedef unsigned u32x2 __attribute__((ext_vector_type(2)));
typedef short v4i16_t __attribute__((ext_vector_type(4)));
typedef GAS unsigned gu32;
#define RLX_AGENT __ATOMIC_RELAXED, __HIP_MEMORY_SCOPE_AGENT
#define LDS_WAIT() asm volatile("s_waitcnt lgkmcnt(0)" ::: "memory")
#define VM_WAIT() asm volatile("s_waitcnt vmcnt(0)" ::: "memory")
#define WG_BAR() do { asm volatile("s_waitcnt lgkmcnt(0)" ::: "memory"); __builtin_amdgcn_s_barrier(); asm volatile("" ::: "memory"); } while (0)
using pg8::cvt_pk_bf16; using pg8::bflo; using pg8::bfhi; using pg8::silu_f;
__device__ __forceinline__ f32x4 mfma16(bf16x8 a, bf16x8 b, f32x4 c) { return __builtin_amdgcn_mfma_f32_16x16x32_bf16(a, b, c, 0, 0, 0); }
__device__ __forceinline__ v4i16_t vtr(const LAS unsigned char* p) { return __builtin_amdgcn_ds_read_tr16_b64_v4i16((LAS v4i16_t*)p); }
__device__ __forceinline__ bf16x8 cat8(v4i16_t lo, v4i16_t hi) { return (bf16x8){lo[0], lo[1], lo[2], lo[3], hi[0], hi[1], hi[2], hi[3]}; }
__device__ __forceinline__ float wave_sum(float v) {
#pragma unroll
    for (int o = 1; o < 64; o <<= 1) v += __shfl_xor(v, o);
    return v;
}

namespace att {
constexpr int KSTR = 144;
constexpr int LDS_K = 0, LDS_V = 256 * KSTR, LDS_BYTES = 2 * 256 * KSTR;
struct UnitRegs { u32x4 kv[4], vv[4]; bf16x8 qf[2]; };
struct UnitIdx { int p, b, h, dl, r, nb; };
__device__ __forceinline__ UnitIdx decode(int u, int half) {
    UnitIdx x; x.p = u >> 10; const int rem = u & 1023, bh = rem >> 5, xx = rem & 31; x.b = 4 * half + (bh >> 3); x.h = bh & 7;
    x.dl = (x.p == 0) ? 1 : (x.p == 1) ? 4 : 16; const int lgn = (x.p == 0) ? 5 : (x.p == 1) ? 3 : 1;
    x.r = xx >> lgn; x.nb = xx & ((1 << lgn) - 1); return x;
}
__device__ __forceinline__ void load_unit(UnitRegs& R, const bf16* Q, const bf16* K, const bf16* V, int u, int half) {
    const int tid = TIDX(), lane = tid & 63, wid = __builtin_amdgcn_readfirstlane(tid >> 6), ql = lane & 15, g = lane >> 4;
    const UnitIdx x = decode(u, half); const size_t rowb = (size_t)x.b * SEQ;
#pragma unroll
    for (int i = 0; i < 4; ++i) {
        const int q = tid + 512 * i, j = q >> 3, c8 = q & 7, mi = 128 * (x.nb - 1) + j;
        R.kv[i] = (u32x4){0u, 0u, 0u, 0u}; R.vv[i] = R.kv[i];
        if (mi >= 0) { const size_t src = (rowb + (size_t)(mi * x.dl + x.r)) * 512 + x.h * 64 + c8 * 8; R.kv[i] = *(const u32x4*)(K + src); R.vv[i] = *(const u32x4*)(V + src); }
    }
    const int iq = 16 * wid + ql; const size_t qrow = rowb + (size_t)((128 * x.nb + iq) * x.dl + x.r);
#pragma unroll
    for (int ks = 0; ks < 2; ++ks) R.qf[ks] = *(const bf16x8*)(Q + qrow * 512 + x.h * 64 + 32 * ks + 8 * g);
}
__device__ __forceinline__ void attn_units(LAS unsigned char* lds, const bf16* Q, const bf16* K, const bf16* V, bf16* OP, float* LSE, int u0, int n, int half) {
    const int tid = TIDX(), lane = tid & 63, wid = __builtin_amdgcn_readfirstlane(tid >> 6), ql = lane & 15, g = lane >> 4;
    if (n <= 0) return;
    UnitRegs R; load_unit(R, Q, K, V, u0, half);
    for (int ui = 0; ui < n; ++ui) {
        const int u = u0 + ui; const UnitIdx x = decode(u, half); const int nb = x.nb, p = x.p, h = x.h;
#pragma unroll
        for (int i = 0; i < 4; ++i) { const int q = tid + 512 * i, j = q >> 3, c8 = q & 7;
            *(LAS u32x4*)(lds + LDS_K + j * KSTR + c8 * 16) = R.kv[i]; *(LAS u32x4*)(lds + LDS_V + j * KSTR + c8 * 16) = R.vv[i]; }
        const bf16x8 qf0 = R.qf[0], qf1 = R.qf[1];
        WG_BAR();
        if (ui + 1 < n) load_unit(R, Q, K, V, u + 1, half);
        const int iq = 16 * wid + ql; const size_t qrow = (size_t)x.b * SEQ + (size_t)((128 * nb + iq) * x.dl + x.r);
        float sc[9][4]; float mx = -INFINITY;
#pragma unroll
        for (int tt = 0; tt < 9; ++tt) {
            const int jt = wid + tt;
            if (nb > 0 || jt >= 8) {
                f32x4 a = (f32x4){0.f, 0.f, 0.f, 0.f};
                { const bf16x8 kf = *(const LAS bf16x8*)(lds + LDS_K + (16 * jt + ql) * KSTR + 16 * g); a = mfma16(kf, qf0, a); }
                { const bf16x8 kf = *(const LAS bf16x8*)(lds + LDS_K + (16 * jt + ql) * KSTR + 64 + 16 * g); a = mfma16(kf, qf1, a); }
#pragma unroll
                for (int rg = 0; rg < 4; ++rg) {
                    float v = a[rg];
                    if (tt == 0) v = (4 * g + rg >= ql) ? v : -INFINITY;
                    if (tt == 8) v = (4 * g + rg <= ql) ? v : -INFINITY;
                    sc[tt][rg] = v; mx = fmaxf(mx, v); }
            } else {
#pragma unroll
                for (int rg = 0; rg < 4; ++rg) sc[tt][rg] = -INFINITY;
            }
        }
        mx = fmaxf(mx, __shfl_xor(mx, 16)); mx = fmaxf(mx, __shfl_xor(mx, 32));
        float l = 0.f;
#pragma unroll
        for (int tt = 0; tt < 9; ++tt)
#pragma unroll
            for (int rg = 0; rg < 4; ++rg) { sc[tt][rg] = __builtin_amdgcn_exp2f(sc[tt][rg] - mx); l += sc[tt][rg]; }
        l += __shfl_xor(l, 16); l += __shfl_xor(l, 32);
        f32x4 o[4];
#pragma unroll
        for (int dt = 0; dt < 4; ++dt) o[dt] = (f32x4){0.f, 0.f, 0.f, 0.f};
#pragma unroll
        for (int pp = 0; pp < 5; ++pp) {
            const int t0 = wid + 2 * pp; int t1 = t0 + 1; if (t1 > 15) t1 = 15;
            u32x4 pw;
            pw.x = cvt_pk_bf16(sc[2 * pp][0], sc[2 * pp][1]); pw.y = cvt_pk_bf16(sc[2 * pp][2], sc[2 * pp][3]);
            if (pp < 4) { pw.z = cvt_pk_bf16(sc[2 * pp + 1][0], sc[2 * pp + 1][1]); pw.w = cvt_pk_bf16(sc[2 * pp + 1][2], sc[2 * pp + 1][3]); } else { pw.z = 0u; pw.w = 0u; }
            const bf16x8 pf = __builtin_bit_cast(bf16x8, pw);
            const LAS unsigned char* v0 = lds + LDS_V + (16 * t0 + 4 * g + (ql >> 2)) * KSTR + 8 * (ql & 3);
            const LAS unsigned char* v1 = lds + LDS_V + (16 * t1 + 4 * g + (ql >> 2)) * KSTR + 8 * (ql & 3);
#pragma unroll
            for (int dt = 0; dt < 4; ++dt) { const bf16x8 vf = cat8(vtr(v0 + 32 * dt), vtr(v1 + 32 * dt)); o[dt] = mfma16(vf, pf, o[dt]); }
        }
        const float il = __builtin_amdgcn_rcpf(l);
        bf16* orow = OP + ((size_t)p * pg8::MH + qrow) * 512 + h * 64 + 4 * g;
#pragma unroll
        for (int dt = 0; dt < 4; ++dt) { u32x2 w; w.x = cvt_pk_bf16(o[dt][0] * il, o[dt][1] * il); w.y = cvt_pk_bf16(o[dt][2] * il, o[dt][3] * il); *(u32x2*)(orow + 16 * dt) = w; }
        if (g == 0) LSE[((size_t)p * M_TOK + qrow) * 8 + h] = mx + __builtin_amdgcn_logf(l);
        WG_BAR();
    }
}
}

__device__ __forceinline__ void merge_sconv_phase(int gtid, int nthreads, const bf16* __restrict__ OP, const float* __restrict__ LSE, const bf16* __restrict__ GB, const bf16* __restrict__ PR, const float* __restrict__ scw, bf16* __restrict__ AB, int half) {
    const int grp = gtid & 127, N = pg8::MH * 128;
    if (grp < 64) {
        const int h = grp >> 3;
        for (int it = gtid; it < N; it += 2 * nthreads) {
            const bool two = it + nthreads < N;
            const int row0 = half * pg8::MH + (it >> 7), row1 = two ? half * pg8::MH + ((it + nthreads) >> 7) : row0;
            float l[2][3]; u32x4 x[2][3];
#pragma unroll
            for (int i = 0; i < 2; ++i) { const int row = i ? row1 : row0;
#pragma unroll
                for (int p = 0; p < 3; ++p) { l[i][p] = LSE[((size_t)p * M_TOK + row) * 8 + h]; x[i][p] = *(const u32x4*)(OP + ((size_t)p * pg8::MH + row) * 512 + grp * 8); } }
#pragma unroll
            for (int i = 0; i < 2; ++i) { const int row = i ? row1 : row0;
                const float mx = fmaxf(l[i][0], fmaxf(l[i][1], l[i][2]));
                float w0 = __builtin_amdgcn_exp2f(l[i][0] - mx), w1 = __builtin_amdgcn_exp2f(l[i][1] - mx), w2 = __builtin_amdgcn_exp2f(l[i][2] - mx);
                const float inv = __builtin_amdgcn_rcpf(w0 + w1 + w2); w0 *= inv; w1 *= inv; w2 *= inv;
                float r[8];
#pragma unroll
                for (int j = 0; j < 4; ++j) { r[2 * j] = w0 * bflo(x[i][0][j]) + w1 * bflo(x[i][1][j]) + w2 * bflo(x[i][2][j]); r[2 * j + 1] = w0 * bfhi(x[i][0][j]) + w1 * bfhi(x[i][1][j]) + w2 * bfhi(x[i][2][j]); }
                u32x4 w; w.x = cvt_pk_bf16(r[0], r[1]); w.y = cvt_pk_bf16(r[2], r[3]); w.z = cvt_pk_bf16(r[4], r[5]); w.w = cvt_pk_bf16(r[6], r[7]);
                if (i == 0 || two) *(u32x4*)(AB + (size_t)row * 1024 + grp * 8) = w; }
        }
    } else {
        const int c0 = (grp - 64) * 8;
        f32x4 wa[3], wb[3];
#pragma unroll
        for (int k = 0; k < 3; ++k) { wa[k] = *(const f32x4*)(scw + k * 512 + c0); wb[k] = *(const f32x4*)(scw + k * 512 + c0 + 4); }
        for (int it = gtid; it < N; it += 2 * nthreads) {
            const bool two = it + nthreads < N;
            const int row0 = half * pg8::MH + (it >> 7), row1 = two ? half * pg8::MH + ((it + nthreads) >> 7) : row0;
            u32x4 gb[2], pr[2][3];
#pragma unroll
            for (int i = 0; i < 2; ++i) { const int row = i ? row1 : row0, t = row & (SEQ - 1);
                gb[i] = *(const u32x4*)(GB + (size_t)row * 512 + c0);
#pragma unroll
                for (int k = 0; k < 3; ++k) pr[i][k] = (t >= 2 - k) ? *(const u32x4*)(PR + (size_t)(row - (2 - k)) * 512 + c0) : (u32x4){0u, 0u, 0u, 0u}; }
#pragma unroll
            for (int i = 0; i < 2; ++i) { const int row = i ? row1 : row0;
                float acc[8];
#pragma unroll
                for (int j = 0; j < 8; ++j) acc[j] = 0.f;
#pragma unroll
                for (int k = 0; k < 3; ++k)
#pragma unroll
                    for (int j = 0; j < 4; ++j) { const float wl = (j < 2) ? wa[k][2 * j] : wb[k][2 * j - 4], wh = (j < 2) ? wa[k][2 * j + 1] : wb[k][2 * j - 3];
                        acc[2 * j] += wl * bflo(pr[i][k][j]); acc[2 * j + 1] += wh * bfhi(pr[i][k][j]); }
                u32x4 w; w.x = cvt_pk_bf16(bflo(gb[i].x) * acc[0], bfhi(gb[i].x) * acc[1]); w.y = cvt_pk_bf16(bflo(gb[i].y) * acc[2], bfhi(gb[i].y) * acc[3]);
                w.z = cvt_pk_bf16(bflo(gb[i].z) * acc[4], bfhi(gb[i].z) * acc[5]); w.w = cvt_pk_bf16(bflo(gb[i].w) * acc[6], bfhi(gb[i].w) * acc[7]);
                if (i == 0 || two) *(u32x4*)(AB + (size_t)row * 1024 + grp * 8) = w; }
        }
    }
}

namespace ret {
constexpr int KRS = 528, VRS = 144;
constexpr int SA_LDS_BYTES = 2 * 128 * KRS;
__device__ __forceinline__ void score_tiles(LAS unsigned char* kl, const bf16x8 (&qf)[8], bf16* P, int ch, int qt, int ql, int g) {
    const int iq = 16 * qt + ql;
    bf16* prow = P + ((size_t)ch * 128 + iq) * 128 + 4 * g;
#pragma unroll 1
    for (int kt = 0; kt <= qt; ++kt) {
        f32x4 a = (f32x4){0.f, 0.f, 0.f, 0.f};
#pragma unroll
        for (int ks = 0; ks < 8; ++ks) { const bf16x8 kf = *(const LAS bf16x8*)(kl + (16 * kt + ql) * KRS + 64 * ks + 16 * g); a = mfma16(kf, qf[ks], a); }
        float pr[4];
#pragma unroll
        for (int rg = 0; rg < 4; ++rg) pr[rg] = (16 * kt + 4 * g + rg <= iq) ? a[rg] : 0.f;
        u32x2 w; w.x = cvt_pk_bf16(pr[0], pr[1]); w.y = cvt_pk_bf16(pr[2], pr[3]); *(u32x2*)(prow + 16 * kt) = w;
    }
    if ((qt & 1) == 0) *(u32x2*)(prow + 16 * (qt + 1)) = (u32x2){0u, 0u};
}
__device__ __forceinline__ void score_pair(LAS unsigned char* lds, const bf16* Q, const bf16* K, bf16* P, int pr) {
    const int tid = TIDX(), lane = tid & 63, wid = __builtin_amdgcn_readfirstlane(tid >> 6), ql = lane & 15, g = lane >> 4;
    bf16x8 qfa[8], qfb[8];
#pragma unroll
    for (int s = 0; s < 2; ++s) {
        const int ch = 2 * pr + s, b = ch >> 7, h = (ch >> 5) & 3, c = ch & 31; const size_t t0 = (size_t)b * SEQ + 128 * c;
        u32x4 kr[8];
#pragma unroll
        for (int i = 0; i < 8; ++i) { const int q = tid + 512 * i, key = q >> 5, c16 = q & 31; kr[i] = *(const u32x4*)(K + (t0 + key) * 1024 + h * 256 + c16 * 8); }
        const int iq = 16 * (s ? 7 - wid : wid) + ql;
#pragma unroll
        for (int ks = 0; ks < 8; ++ks) { const bf16x8 v = *(const bf16x8*)(Q + (t0 + iq) * 1024 + h * 256 + 32 * ks + 8 * g); if (s) qfb[ks] = v; else qfa[ks] = v; }
#pragma unroll
        for (int i = 0; i < 8; ++i) { const int q = tid + 512 * i, key = q >> 5, c16 = q & 31; *(LAS u32x4*)(lds + s * 128 * KRS + key * KRS + c16 * 16) = kr[i]; }
    }
    WG_BAR();
    score_tiles(lds, qfa, P, 2 * pr, wid, ql, g);
    score_tiles(lds + 128 * KRS, qfb, P, 2 * pr + 1, 7 - wid, ql, g);
    WG_BAR();
}

constexpr int SRS = 544;
constexpr int LDS_KC = 0, LDS_VK = 128 * KRS, LDS_SB = LDS_VK + 128 * VRS, LDS_BYTES = LDS_SB + 64 * SRS;
struct ChunkRegs { u32x4 k[8], v[2]; bf16x8 p[4]; };
__device__ __forceinline__ void load_chunk(ChunkRegs& R, const bf16* K, const bf16* V, const bf16* P, size_t t0, int ch, int h, int sl, int qt) {
    const int tid = TIDX(), lane = tid & 63, wid = __builtin_amdgcn_readfirstlane(tid >> 6), ql = lane & 15, g = lane >> 4;
#pragma unroll
    for (int i = 0; i < 8; ++i) { const int q = tid + 512 * i, key = q >> 5, c16 = q & 31; R.k[i] = *(const u32x4*)(K + (t0 + key) * 1024 + h * 256 + c16 * 8); }
#pragma unroll
    for (int i = 0; i < 2; ++i) { const int q = tid + 512 * i, key = q >> 3, c8 = q & 7; R.v[i] = *(const u32x4*)(V + (t0 + key) * 2048 + h * 512 + sl * 64 + c8 * 8); }
    const bf16* prow = P + ((size_t)ch * 128 + 16 * qt + ql) * 128 + 8 * g;
#pragma unroll
    for (int kp = 0; kp < 4; ++kp) R.p[kp] = (2 * kp <= qt) ? *(const bf16x8*)(prow + 32 * kp) : (bf16x8){0, 0, 0, 0, 0, 0, 0, 0};
}
__device__ __forceinline__ void load_q(bf16x8 (&qf)[8], const bf16* Q, size_t t0, int h, int qt) {
    const int tid = TIDX(), lane = tid & 63, wid = __builtin_amdgcn_readfirstlane(tid >> 6), ql = lane & 15, g = lane >> 4;
    const int iq = 16 * qt + ql;
#pragma unroll
    for (int ks = 0; ks < 8; ++ks) qf[ks] = *(const bf16x8*)(Q + (t0 + iq) * 1024 + h * 256 + 32 * ks + 8 * g);
}
__device__ __forceinline__ void ret_item(LAS unsigned char* lds, const bf16* Q, const bf16* K, bf16* V, const bf16* P, float* GNS, int item) {
    const int tid = TIDX(), lane = tid & 63, wid = __builtin_amdgcn_readfirstlane(tid >> 6), ql = lane & 15, g = lane >> 4;
    const int b = item >> 5, h = (item >> 3) & 3, sl = item & 7, ch0 = (b * 4 + h) * 32;
    const float lg = __builtin_amdgcn_logf(1.0f - __builtin_amdgcn_exp2f((float)(-5 - h)));
    const float cdec = __builtin_amdgcn_exp2f(lg * 128.0f);
    const int qt = wid < 4 ? wid : 11 - wid;
    ChunkRegs R; load_chunk(R, K, V, P, (size_t)b * SEQ, ch0, h, sl, qt);
    bf16x8 qf[8]; load_q(qf, Q, (size_t)b * SEQ, h, qt);
    f32x4 st[2][4];
#pragma unroll
    for (int dd = 0; dd < 2; ++dd)
#pragma unroll
        for (int et = 0; et < 4; ++et) st[dd][et] = (f32x4){0.f, 0.f, 0.f, 0.f};
    const int iq = 16 * qt + ql;
    const float qdec = __builtin_amdgcn_exp2f(lg * (float)(iq + 1)), pdec = __builtin_amdgcn_exp2f(lg * (float)(iq - 127));
    for (int c = 0; c < 32; ++c) {
        const size_t t0 = (size_t)b * SEQ + 128 * c;
#pragma unroll
        for (int i = 0; i < 8; ++i) { const int q = tid + 512 * i, key = q >> 5, c16 = q & 31; *(LAS u32x4*)(lds + LDS_KC + key * KRS + c16 * 16) = R.k[i]; }
#pragma unroll
        for (int i = 0; i < 2; ++i) { const int q = tid + 512 * i, key = q >> 3, c8 = q & 7;
            const u32x4 v = R.v[i];
            const float kd = __builtin_amdgcn_exp2f(lg * (float)(127 - key));
            u32x4 vk;
            vk.x = cvt_pk_bf16(bflo(v.x) * kd, bfhi(v.x) * kd); vk.y = cvt_pk_bf16(bflo(v.y) * kd, bfhi(v.y) * kd); vk.z = cvt_pk_bf16(bflo(v.z) * kd, bfhi(v.z) * kd); vk.w = cvt_pk_bf16(bflo(v.w) * kd, bfhi(v.w) * kd);
            *(LAS u32x4*)(lds + LDS_VK + key * VRS + c8 * 16) = vk; }
#pragma unroll
        for (int dd = 0; dd < 2; ++dd)
#pragma unroll
            for (int et = 0; et < 4; ++et) { u32x2 w; w.x = cvt_pk_bf16(st[dd][et][0], st[dd][et][1]); w.y = cvt_pk_bf16(st[dd][et][2], st[dd][et][3]);
                *(LAS u32x2*)(lds + LDS_SB + (16 * et + ql) * SRS + (32 * wid + 16 * dd + 4 * g) * 2) = w; }
        bf16x8 pf[4];
#pragma unroll
        for (int kp = 0; kp < 4; ++kp) pf[kp] = R.p[kp];
        WG_BAR();
        if (c + 1 < 32) load_chunk(R, K, V, P, t0 + 128, ch0 + c + 1, h, sl, qt);
        f32x4 o[4], qs[4];
#pragma unroll
        for (int et = 0; et < 4; ++et) { o[et] = (f32x4){0.f, 0.f, 0.f, 0.f}; qs[et] = o[et]; }
#pragma unroll
        for (int kp = 0; kp < 4; ++kp) {
            if (2 * kp <= qt) {
                const LAS unsigned char* v0 = lds + LDS_VK + (32 * kp + 8 * g + (ql >> 2)) * VRS + 8 * (ql & 3);
#pragma unroll
                for (int et = 0; et < 4; ++et) { const bf16x8 vf = cat8(vtr(v0 + 32 * et), vtr(v0 + 4 * VRS + 32 * et)); o[et] = mfma16(vf, pf[kp], o[et]); }
            }
        }
#pragma unroll
        for (int dd = 0; dd < 2; ++dd)
#pragma unroll
            for (int et = 0; et < 4; ++et) st[dd][et] = st[dd][et] * cdec;
#pragma unroll 1
        for (int kk = 0; kk < 4; ++kk) {
            bf16x8 kfr[2], vfr[4];
            const LAS unsigned char* k0 = lds + LDS_KC + (32 * kk + 8 * g + (ql >> 2)) * KRS + 64 * wid + 8 * (ql & 3);
            const LAS unsigned char* v0 = lds + LDS_VK + (32 * kk + 8 * g + (ql >> 2)) * VRS + 8 * (ql & 3);
#pragma unroll
            for (int dd = 0; dd < 2; ++dd) kfr[dd] = cat8(vtr(k0 + 32 * dd), vtr(k0 + 4 * KRS + 32 * dd));
#pragma unroll
            for (int et = 0; et < 4; ++et) vfr[et] = cat8(vtr(v0 + 32 * et), vtr(v0 + 4 * VRS + 32 * et));
#pragma unroll
            for (int dd = 0; dd < 2; ++dd)
#pragma unroll
                for (int et = 0; et < 4; ++et) st[dd][et] = mfma16(kfr[dd], vfr[et], st[dd][et]);
        }
#pragma unroll
        for (int ks = 0; ks < 8; ++ks) {
#pragma unroll
            for (int et = 0; et < 4; ++et) { const bf16x8 sf = *(const LAS bf16x8*)(lds + LDS_SB + (16 * et + ql) * SRS + 64 * ks + 16 * g); qs[et] = mfma16(sf, qf[ks], qs[et]); }
        }
        float s1 = 0.f, s2 = 0.f;
        bf16* orow = V + (t0 + iq) * 2048 + h * 512 + sl * 64 + 4 * g;
#pragma unroll
        for (int et = 0; et < 4; ++et) {
            const f32x4 r = o[et] * pdec + qs[et] * qdec;
            s1 += (r[0] + r[1]) + (r[2] + r[3]); s2 += (r[0] * r[0] + r[1] * r[1]) + (r[2] * r[2] + r[3] * r[3]);
            u32x2 w; w.x = cvt_pk_bf16(r[0], r[1]); w.y = cvt_pk_bf16(r[2], r[3]); *(u32x2*)(orow + 16 * et) = w;
        }
        s1 = pg8::xor16_32_sum(s1); s2 = pg8::xor16_32_sum(s2);
        if (g == 0) { float* gp = GNS + (((size_t)(t0 + iq)) * 4 + h) * 16 + sl * 2; gp[0] = s1; gp[1] = s2; }
        WG_BAR();
        if (c + 1 < 32) load_q(qf, Q, t0 + 128, h, qt);
    }
}
}

constexpr size_t MiB = 1u << 20;
constexpr size_t WS_CTL = 0, CTL_ZERO_BYTES = 160 * 1024;
constexpr size_t WS_SSQ = 1 * MiB;
constexpr size_t WS_GNS = 3 * MiB;
constexpr size_t WS_COS = 11 * MiB, WS_SIN = 13 * MiB;
constexpr size_t WS_UF = 15 * MiB, WS_UL = 21 * MiB;
constexpr size_t WS_LSE = 27 * MiB;
constexpr size_t WS_MR = 30 * MiB;
constexpr size_t WS_WIN = 32 * MiB, WS_WOUT = 38 * MiB, WS_WQKV = 40 * MiB, WS_WG = 48 * MiB, WS_WO = 52 * MiB, WS_UP0 = 56 * MiB, WS_UP1 = 67 * MiB;
constexpr size_t WS_DN0 = 78 * MiB, WS_DN1 = WS_DN0 + (size_t)DM * DFF * 2;
constexpr size_t WS_XB = 90 * MiB;
constexpr size_t WS_R = 154 * MiB, HALF_REGION = 176 * MiB;
constexpr size_t RO_PROJ = 0;
constexpr size_t RO_OP = 80 * MiB;
constexpr size_t RO_AB = 128 * MiB;
constexpr size_t RO_HID = 0;
constexpr size_t RO_Q1 = 0, RO_K1 = 32 * MiB, RO_V1 = 64 * MiB;
constexpr size_t RO_PS = 128 * MiB;
constexpr size_t WS_END = WS_R + 2 * HALF_REGION;
static_assert(WS_DN1 + (size_t)DM * DFF * 2 <= WS_XB && WS_END <= 512 * MiB && RO_AB + 32 * MiB <= HALF_REGION && RO_PS + 16 * MiB <= HALF_REGION, "d_ws map");

constexpr int RING_OFF = 0, RING_BYTES = 131072;
constexpr int XCH_OFF = RING_BYTES, XCH_BYTES = 24576;
constexpr int MISC_OFF = XCH_OFF + XCH_BYTES;
constexpr int LDS_BYTES = 163840;
static_assert(att::LDS_BYTES <= MISC_OFF && ret::LDS_BYTES <= MISC_OFF && ret::SA_LDS_BYTES <= MISC_OFF && MISC_OFF + 256 <= LDS_BYTES, "LDS map");
constexpr int NWAVES = 8;

constexpr int N_EVENTS = 28;
#define EV_TMO       128
#define EV_XCNT(j)   (256 + 64 * (j))
#define EV_XSUB(e,j) (2048 + 64 * (16 * (e) + (j)))
#define EV_TOP(e)    (32768 + 64 * (e))
#define EV_DONE(e)   (36864 + 64 * (e))
static_assert((36864 + 64 * N_EVENTS) * 4 <= (int)CTL_ZERO_BYTES && 2048 + 64 * 16 * N_EVENTS <= 32768, "event words inside the memset region");
#define EV_SPIN_CAP (1u << 22)
__device__ __forceinline__ unsigned ev_ld(unsigned* p)              { return __hip_atomic_load(p, __ATOMIC_RELAXED, __HIP_MEMORY_SCOPE_AGENT); }
__device__ __forceinline__ unsigned ev_add(unsigned* p, unsigned v) { return __hip_atomic_fetch_add(p, v, __ATOMIC_RELAXED, __HIP_MEMORY_SCOPE_AGENT); }
__device__ __forceinline__ unsigned ev_xcc_id() { return (unsigned)__builtin_amdgcn_s_getreg((3 << 11) | 20) & 0xFu; }
#define EV_SPIN(cond, ctl) do { unsigned _sp = 0; while (cond) { __builtin_amdgcn_s_sleep(1); \
    if ((++_sp & 255u) == 0u) { if (ev_ld(&(ctl)[EV_TMO])) break; if (_sp > EV_SPIN_CAP) { atomicAdd(&(ctl)[EV_TMO], 1u); break; } } } } while (0)
struct Events { unsigned* ctl; unsigned x; volatile LAS unsigned* st; };
__device__ __forceinline__ Events events_post(unsigned* ctl, volatile LAS unsigned* st) {
    Events b; b.ctl = ctl; b.x = ev_xcc_id(); b.st = st;
    if (threadIdx.x == 0) (void)ev_add(&ctl[EV_XCNT(b.x)], 1u);
    return b;
}
__device__ __forceinline__ void events_census(unsigned* ctl, unsigned x, unsigned& nloc, unsigned& nx) {
    const unsigned G = gridDim.x * gridDim.y * gridDim.z;
    unsigned sum, cnt, mine, sp = 0u;
    for (;;) {
        sum = 0u; cnt = 0u; mine = 0u;
#pragma unroll
        for (unsigned j = 0; j < 16; ++j) { const unsigned c = ev_ld(&ctl[EV_XCNT(j)]); sum += c; cnt += (c > 0u) ? 1u : 0u; mine = (j == x) ? c : mine; }
        if (sum == G) break;
        __builtin_amdgcn_s_sleep(1);
        if ((++sp & 255u) == 0u) { if (ev_ld(&ctl[EV_TMO])) break; if (sp > EV_SPIN_CAP) { atomicAdd(&ctl[EV_TMO], 1u); break; } }
    }
    nloc = mine > 0u ? mine : 1u; nx = cnt > 0u ? cnt : 1u;
}
__device__ __forceinline__ void ev_step(const Events& b, int ea, int ew) {
    unsigned* ctl = b.ctl;
    const int tid = TIDX();
    unsigned d = 1u, old = 0u;
    if (ew >= 0 && tid == 64) d = (b.st[5] == (unsigned)(ew + 1)) ? 2u : ev_ld(&ctl[EV_DONE(ew)]);
    asm volatile("s_waitcnt vmcnt(0)" ::: "memory");
    WG_BAR();
    if (ea >= 0 && tid == 128) old = ev_add(&ctl[EV_XSUB(ea, b.x)], 1u);
    if (ew >= 0 && tid == 64 && d != 2u) {
        if (d == 0u) EV_SPIN(ev_ld(&ctl[EV_DONE(ew)]) == 0u, ctl);
        __builtin_amdgcn_fence(__ATOMIC_ACQUIRE, "agent");
        asm volatile("s_waitcnt vmcnt(0)" ::: "memory");
    }
    WG_BAR();
    if (ea >= 0 && tid == 128) {
        unsigned nloc = b.st[0], nx = b.st[1];
        if (nloc == 0u) { events_census(ctl, b.x, nloc, nx); b.st[0] = nloc; b.st[1] = nx; }
        if (old + 1u == nloc) {
            __builtin_amdgcn_fence(__ATOMIC_RELEASE, "agent");
            asm volatile("s_waitcnt vmcnt(0)" ::: "memory");
            const unsigned og = ev_add(&ctl[EV_TOP(ea)], 1u);
            if (og + 1u == nx) __hip_atomic_store(&ctl[EV_DONE(ea)], 1u, __ATOMIC_RELAXED, __HIP_MEMORY_SCOPE_AGENT);
        }
    }
}

__device__ __forceinline__ void ev_wait_wave(unsigned* ctl, volatile LAS unsigned* flag, int e) {
    const int wid = __builtin_amdgcn_readfirstlane(TIDX() >> 6);
    if (wid == 0) {
        EV_SPIN(ev_ld(&ctl[EV_DONE(e)]) == 0u, ctl);
        __builtin_amdgcn_fence(__ATOMIC_ACQUIRE, "agent");
        asm volatile("s_waitcnt vmcnt(0)" ::: "memory");
        *flag = (unsigned)(e + 1);
        asm volatile("s_waitcnt lgkmcnt(0)" ::: "memory");
    } else {
        EV_SPIN(*flag != (unsigned)(e + 1), ctl);
    }
}
__device__ __forceinline__ void ev_arrive_inl(const Events& b, int e) {
    asm volatile("s_waitcnt vmcnt(0)" ::: "memory");
    WG_BAR();
    if (TIDX() == 128) {
        unsigned* ctl = b.ctl;
        const unsigned nloc = b.st[0], nx = b.st[1];
        const unsigned old = ev_add(&ctl[EV_XSUB(e, b.x)], 1u);
        if (old + 1u == nloc) {
            __builtin_amdgcn_fence(__ATOMIC_RELEASE, "agent");
            asm volatile("s_waitcnt vmcnt(0)" ::: "memory");
            const unsigned og = ev_add(&ctl[EV_TOP(e)], 1u);
            if (og + 1u == nx) __hip_atomic_store(&ctl[EV_DONE(e)], 1u, __ATOMIC_RELAXED, __HIP_MEMORY_SCOPE_AGENT);
        }
    }
}
struct PairOrder {
    int nN, nwg, G, c0, c1, nA; size_t a_hd; unsigned* ctl; unsigned x; volatile LAS unsigned* st; int ea, ew;
    __device__ __forceinline__ void init(int N, int G_, int c, size_t a_half_delta, const Events& e, int e_arrive, int e_wait) {
        nN = N / pg8::BM; nwg = (pg8::MH / pg8::BM) * nN; G = G_; c0 = c; c1 = G_ - 1 - c; nA = c < nwg ? (nwg - c + G_ - 1) / G_ : 0;
        a_hd = a_half_delta; ctl = e.ctl; x = e.x; st = e.st; ea = e_arrive; ew = e_wait; }
    __device__ __forceinline__ bool next(int i, pg8::Unit& u) const {
        const bool h = i >= nA; const long L = (long)(h ? i - nA : i) * G + (h ? c1 : c0); if (L >= nwg) return false;
        int wgid = (int)L; { const int q = nwg / pg8::NXCD, r = nwg % pg8::NXCD, xcd = wgid % pg8::NXCD, off = wgid / pg8::NXCD; wgid = (xcd < r ? xcd * (q + 1) : r * (q + 1) + (xcd - r) * q) + off; }
        constexpr int nM = pg8::MH / pg8::BM; const int nig = pg8::WGM * nN, gid = wgid / nig, fm = gid * pg8::WGM, gsz = (nM - fm) < pg8::WGM ? (nM - fm) : pg8::WGM;
        u.pm = fm + ((wgid % nig) % gsz) + (h ? nM : 0); u.pn = (wgid % nig) / gsz; return true; }
    __device__ __forceinline__ void a_ready(const pg8::Unit&, int i) const { if (i == nA && ew >= 0) ev_wait_wave(ctl, st + 4, ew); }
    __device__ __forceinline__ void done(const pg8::Unit&, int i) const { if (i == nA - 1) { Events b; b.ctl = ctl; b.x = x; b.st = st; ev_arrive_inl(b, ea); } }
    __device__ __forceinline__ size_t a_off(const pg8::Unit& u) const { return u.pm >= pg8::MH / pg8::BM ? a_hd : (size_t)0; }
    __device__ __forceinline__ void early() const { pg8::ev_early_acquire(&ctl[EV_DONE(ea)], st + 5, (unsigned)(ea + 1)); }
};

__device__ __forceinline__ int map_col(int mode, int pcol0) {
    if (mode == 0) return pcol0;
    const int pn = pcol0 >> 8, w = pcol0 & 255, bj = w >> 7, q = (w >> 5) & 3;
    if (mode == 1) return pn < 8 ? pn * 256 + q * 64 + bj * 32
                               : (bj ? 2560 : 2048) + (pn - 8) * 128 + q * 32;
    return bj * DFF + pn * 128 + q * 32;
}
__device__ __forceinline__ void transpose_item(const float* W, int K, int N, bf16* WT, int row_off, const float* gain, int mode, int item, int lane, float scale = 1.0f) {
    const int nblk = N / 32, kb = item / nblk, nb = item % nblk, k0 = 64 * kb, n0 = 32 * nb, ln0 = map_col(mode, n0);
    const int q = lane & 7, c = lane >> 3;
    f32x4 w[8];
#pragma unroll
    for (int i = 0; i < 8; ++i) w[i] = *(const f32x4*)(W + (size_t)(k0 + 8 * c + i) * N + ln0 + 4 * q);
    if (gain) { const f32x4 g0 = *(const f32x4*)(gain + k0 + 8 * c) * scale, g1 = *(const f32x4*)(gain + k0 + 8 * c + 4) * scale;
#pragma unroll
        for (int i = 0; i < 4; ++i) { w[i] = w[i] * g0[i]; w[4 + i] = w[4 + i] * g1[i]; } }
#pragma unroll
    for (int j = 0; j < 4; ++j) {
        u32x4 o; o.x = cvt_pk_bf16(w[0][j], w[1][j]); o.y = cvt_pk_bf16(w[2][j], w[3][j]); o.z = cvt_pk_bf16(w[4][j], w[5][j]); o.w = cvt_pk_bf16(w[6][j], w[7][j]);
        *(u32x4*)(WT + (size_t)(row_off + n0 + 4 * q + j) * K + k0 + 8 * c) = o; }
}

__device__ const float INV_REV[256] = {
  0.15915493667125702f, 6.4206382432985265e-09f,
  0.14810514450073242f, -4.283657428771903e-09f,
  0.13782250881195068f, -6.20796791750422e-09f,
  0.128253772854805f, -5.320577756151579e-09f,
  0.11934936791658401f, 2.2946649025357146e-09f,
  0.11106318980455399f, -2.783397956562794e-09f,
  0.10335229337215424f, 3.246279911550687e-09f,
  0.09617675840854645f, -8.095586423451095e-10f,
  0.08949939906597137f, 2.5429196526260966e-09f,
  0.08328563719987869f, 3.617293797830712e-09f,
  0.07750328630208969f, 2.453284464465355e-09f,
  0.07212239503860474f, -1.4427524730464825e-09f,
  0.06711508333683014f, -3.316028840405494e-10f,
  0.062455419450998306f, 3.183421859453972e-10f,
  0.0581192672252655f, 2.1661074323109375e-10f,
  0.0540841668844223f, -1.5636965056131658e-09f,
  0.050329212099313736f, 5.173299288951938e-12f,
  0.04683495685458183f, 7.718743977314091e-10f,
  0.043583303689956665f, -1.5846493006677065e-09f,
  0.04055740311741829f, -7.268268209514872e-10f,
  0.037741586565971375f, -1.848551645089458e-09f,
  0.035121262073516846f, 1.4448936491717745e-09f,
  0.032682865858078f, 1.4278992051253159e-11f,
  0.030413761734962463f, -5.366916355775686e-10f,
  0.02830219641327858f, -5.826552018639575e-10f,
  0.026337232440710068f, -3.038148344014502e-10f,
  0.02450869232416153f, -4.6209167048338884e-10f,
  0.022807102650403976f, 7.561994919136339e-10f,
  0.021223653107881546f, -3.431038786416707e-10f,
  0.019750138744711876f, -8.754094671381552e-10f,
  0.018378926441073418f, -3.35393740558132e-10f,
  0.017102913931012154f, 8.452463173824754e-10f,
  0.01591549441218376f, -1.0299423119919382e-10f,
  0.014810513705015182f, 3.16692339019653e-10f,
  0.013782250694930553f, -4.345322712762112e-10f,
  0.012825376354157925f, 3.992647878980904e-10f,
  0.011934936977922916f, 4.320196977936064e-11f,
  0.011106318794190884f, -9.207527795762616e-11f,
  0.010335229337215424f, 3.246279911550687e-10f,
  0.00961767602711916f, -2.672203847087218e-10f,
  0.008949940092861652f, 6.802745172729274e-11f,
  0.008328564465045929f, -3.833286743581965e-10f,
  0.007750329095870256f, -2.2033284918787643e-10f,
  0.007212239317595959f, 4.1989262761221724e-11f,
  0.006711508147418499f, 1.531042237434832e-10f,
  0.006245541851967573f, 1.249664816072027e-10f,
  0.005811926908791065f, -1.646034419877651e-10f,
  0.005408416502177715f, 2.9894860892332176e-11f,
  0.005032921209931374f, 5.173298855271069e-13f,
  0.004683495964854956f, -2.0220933261150265e-10f,
  0.004358330275863409f, -6.533267676855914e-11f,
  0.004055740311741829f, -7.268267931959116e-11f,
  0.003774158423766494f, 4.797548469603896e-11f,
  0.0035121263936161995f, -4.177515278147581e-11f,
  0.0032682865858078003f, 1.4278991400731855e-12f,
  0.0030413761269301176f, -7.103032138161547e-12f,
  0.0028302196878939867f, -1.0483165030494845e-10f,
  0.002633723197504878f, 1.6184645637573603e-11f,
  0.0024508691858500242f, 3.5696104275576013e-13f,
  0.0022807102650403976f, 7.561994780358461e-11f,
  0.0021223651710897684f, 1.0538799694037593e-10f,
  0.0019750138744711876f, -8.754094671381552e-11f,
  0.0018378925742581487f, 3.630981973423708e-11f,
  0.0017102914862334728f, -8.60762763149614e-12f,
  0.0015915494877845049f, -5.686555046291453e-11f,
  0.0014810514403507113f, -3.817995919419559e-11f,
  0.001378225046209991f, -2.017016241528946e-11f,
  0.0012825377052649856f, -2.992271361246246e-11f,
  0.001193493721075356f, -1.8962867734395594e-11f,
  0.001110631856136024f, 1.4075536743096695e-11f,
  0.0010335230035707355f, -3.738639606232219e-11f,
  0.0009617675677873194f, 8.202558424152961e-12f,
  0.0008949940092861652f, 6.802744999256927e-12f,
  0.0008328563999384642f, 8.233260427592537e-12f,
  0.0007750329095870256f, -2.2033284918787643e-11f,
  0.000721223943401128f, -7.442605559626614e-12f,
  0.0006711508031003177f, 2.6951954557041802e-11f,
  0.0006245541735552251f, 2.4138179302579665e-11f,
  0.0005811926675960422f, 6.8227203400827996e-12f,
  0.0005408416618593037f, -8.652046093460264e-12f,
  0.0005032921326346695f, -1.1589799432665249e-11f,
  0.0004683495790231973f, -2.758635117214303e-12f,
  0.000435833033407107f, -1.2354033594730307e-11f,
  0.0004055740137118846f, 1.0194030515553454e-11f,
  0.00037741585401818156f, -6.843983713089585e-12f,
  0.00035121262772008777f, 7.464016384128858e-12f,
  0.00032682865276001394f, 5.9635560378801244e-12f,
  0.00030413761851377785f, -6.531069088322461e-12f,
  0.0002830219455063343f, 1.2799900028781508e-11f,
  0.0002633723197504878f, 1.6184644770211865e-12f,
  0.00024508690694347024f, 1.1677228628492742e-11f,
  0.00022807103232480586f, 1.7412285805915029e-12f,
  0.00021223652584012598f, 1.8076506003855686e-12f,
  0.00019750137289520353f, 5.7978205569853e-12f,
  0.00018378926324658096f, -2.189784378131554e-12f,
  0.00017102915444411337f, -6.681529027968702e-12f,
  0.0001591549371369183f, 5.954976962929681e-12f,
  0.00014810514403507113f, -3.817995832683385e-12f,
  0.000137822498800233f, 3.803749849817795e-12f,
  0.00012825377052649856f, -2.9922715780866804e-12f,
  0.00011934937356272712f, -3.351478166171984e-12f,
  0.0001110631856136024f, 1.407553652625626e-12f,
  0.00010335229308111593f, 3.5373182247916413e-12f,
  9.617675823392347e-05f, -6.34935680421389e-13f,
  8.949940092861652e-05f, 6.802744673996275e-13f,
  8.32856385386549e-05f, 2.2785176523321127e-12f,
  7.750328950351104e-05f, -7.481370124101661e-13f,
  7.212239142972976e-05f, 2.166122533078796e-12f,
  6.711508467560634e-05f, -1.6703791128058754e-12f,
  6.24554231762886e-05f, -3.4069481177206873e-12f,
  5.81192689423915e-05f, -1.500515206878661e-12f,
  5.408416473073885e-05f, 5.899869351747022e-13f,
  5.032921035308391e-05f, 1.7514031674589758e-12f,
  4.683495717472397e-05f, 4.5173223885489056e-13f,
  4.358330261311494e-05f, -5.078076088967098e-13f,
  4.0557402826379985e-05f, -4.3578850380740497e-13f,
  3.7741585401818156e-05f, -6.84398392993002e-13f,
  3.5121262044413015e-05f, 1.4739974648833587e-12f,
  3.268286673119292e-05f, -8.588358973646293e-13f,
  3.0413761123782024e-05f, 7.448882954680033e-14f,
  2.8302196369622834e-05f, -5.389994548778143e-13f,
  2.633723124745302e-05f, 8.89442219962483e-13f,
  2.4508692149538547e-05f, -2.8746869793448704e-13f,
  2.2807103960076347e-05f, -5.534729033591923e-13f,
  2.1223651856416836e-05f, 9.083608431409429e-13f,
  1.9750137653318234e-05f, 2.1598415872632615e-13f,
  1.8378925233264454e-05f, 8.724152043143585e-13f,
  1.7102915080613457e-05f, -3.043550112456772e-13f
};

__device__ __forceinline__ void gn_stats_rows(int pm, int head, const float* gns, float* mr, int tid) {
    if (tid < 256) {
        const int row = pm * 256 + tid;
        const f32x4* sp = (const f32x4*)(gns + ((size_t)row * 4 + head) * 16);
        const f32x4 a = sp[0], b = sp[1], c = sp[2], d = sp[3];
        const float s1 = ((a[0] + a[2]) + (b[0] + b[2])) + ((c[0] + c[2]) + (d[0] + d[2])), s2 = ((a[1] + a[3]) + (b[1] + b[3])) + ((c[1] + c[3]) + (d[1] + d[3]));
        const float mu = s1 * (1.0f / 512.0f), var = s2 * (1.0f / 512.0f) - mu * mu;
        float* o = mr + ((size_t)head * M_TOK + row) * 2; o[0] = mu; o[1] = __builtin_amdgcn_rsqf(fmaxf(var, 0.f) + EPS);
    }
}
__device__ __forceinline__ void fixup_rows(int pm, const float* uf, const float* ul, const float* cw, bf16* hid, int tid) {
    if ((pm & 15) == 0) return;
    for (int ch = tid; ch < DFF; ch += 512) {
        const int colg = (ch >> 7) * 256 + (ch & 127), colv = colg + 128;
        const float* l0 = ul + ((size_t)(pm - 1) * 2 + 0) * NUP; const float* l1 = l0 + NUP;
        const float* f0 = uf + ((size_t)pm * 2 + 0) * NUP; const float* f1 = f0 + NUP;
        const float wg0 = cw[ch], wg1 = cw[NUP + ch], wg2 = cw[2 * NUP + ch], wv0 = cw[DFF + ch], wv1 = cw[NUP + DFF + ch], wv2 = cw[2 * NUP + DFF + ch];
        const float g0 = wg0 * l0[colg] + wg1 * l1[colg] + wg2 * f0[colg], v0 = wv0 * l0[colv] + wv1 * l1[colv] + wv2 * f0[colv];
        const float g1 = wg0 * l1[colg] + wg1 * f0[colg] + wg2 * f1[colg], v1 = wv0 * l1[colv] + wv1 * f0[colv] + wv2 * f1[colv];
        hid[(size_t)(pm * 256 + 0) * DFF + ch] = (bf16)(cvt_pk_bf16(silu_f(g0) * v0, 0.f) & 0xffffu);
        hid[(size_t)(pm * 256 + 1) * DFF + ch] = (bf16)(cvt_pk_bf16(silu_f(g1) * v1, 0.f) & 0xffffu);
    }
}

struct Args { const float* in[18]; float* out; unsigned char* ws; int pad0, pad1; };

__global__ void __launch_bounds__(NWAVES * 64, 2) trunk_fwd(Args args) {
    extern __shared__ __attribute__((aligned(16))) unsigned char lds_raw[];
    LAS unsigned char* lds = (LAS unsigned char*)lds_raw;
    volatile LAS unsigned* MISC = (volatile LAS unsigned*)(lds + MISC_OFF);
    const int tid0 = threadIdx.x, wave = __builtin_amdgcn_readfirstlane(tid0 >> 6);
    const int G = gridDim.x, bx = blockIdx.x;
    const int vcu = (G % 8 == 0) ? (bx % 8) * (G / 8) + bx / 8 : bx;
    typedef const Args __attribute__((address_space(4)))* cargs_t;
#define FRESH const int tid = TIDX(), lane = tid & 63; (void)lane; cargs_t A_ = (cargs_t)__builtin_amdgcn_kernarg_segment_ptr(); asm volatile("" : "+s"(A_)); unsigned char* const ws = A_->ws; (void)ws
#define INP(i) (A_->in[i])
#define WSF(off) ((float*)(ws + (off)))
#define WSB(off) ((bf16*)(ws + (off)))
#define HB(off, rb) ((bf16*)(ws + WS_R + (size_t)half * HALF_REGION + (off) - (size_t)half * pg8::MH * (rb)))
#define RA(off) ((bf16*)(ws + WS_R + (off)))
#define HDB(rb) ((size_t)HALF_REGION - (size_t)pg8::MH * (rb))
    const size_t PSZ = (size_t)pg8::MH * 512;

    for (int u = tid0; u < (LDS_BYTES - MISC_OFF) / 4; u += NWAVES * 64) ((LAS unsigned*)(lds + MISC_OFF))[u] = 0u;
    __syncthreads();
    for (int i = bx * (NWAVES * 64) + tid0; i < (int)(CTL_ZERO_BYTES / 4); i += G * NWAVES * 64) __hip_atomic_store((unsigned*)(args.ws + WS_CTL) + i, 0u, __ATOMIC_RELAXED, __HIP_MEMORY_SCOPE_AGENT);
    const int gw = vcu * NWAVES + wave, NGW = G * NWAVES;
#define EV(k, h) (2 * (k) + (h))
#define ENTER(k)
#define LEAVE(k) ev_step(ev, EV(k, half), half == 0 ? ((k) > 0 ? EV((k) - 1, 1) : -1) : EV(k, 0))

#pragma unroll 1
    for (int half = 0; half < 2; ++half) {
        FRESH;
        if (half == 0) {
            constexpr int I_IN = 16 * 96, I_OUT = 16 * 32, I_Q = 16 * 32, I_V = 16 * 64, I_O = 32 * 32, I_UP = 16 * 176, I_DN = 44 * 32;
            constexpr int NITEMS = I_IN + I_OUT + 2 * I_Q + 2 * I_V + I_O + 2 * I_UP + 2 * I_DN;
            for (int it = gw; it < NITEMS; it += NGW) {
                int r = it;
                if (r < I_IN) { transpose_item(INP(2), 1024, 3072, WSB(WS_WIN), 0, INP(1), 1, r, lane); continue; } r -= I_IN;
                if (r < I_OUT) { transpose_item(INP(6), 1024, 1024, WSB(WS_WOUT), 0, nullptr, 0, r, lane); continue; } r -= I_OUT;
                if (r < I_Q) { transpose_item(INP(8), 1024, 1024, WSB(WS_WQKV), 0, INP(7), 0, r, lane); continue; } r -= I_Q;
                if (r < I_Q) { transpose_item(INP(9), 1024, 1024, WSB(WS_WQKV), 1024, INP(7), 0, r, lane, 0.0625f); continue; } r -= I_Q;
                if (r < I_V) { transpose_item(INP(10), 1024, 2048, WSB(WS_WQKV), 2048, INP(7), 0, r, lane); continue; } r -= I_V;
                if (r < I_V) { transpose_item(INP(11), 1024, 2048, WSB(WS_WG), 0, INP(7), 0, r, lane); continue; } r -= I_V;
                if (r < I_O) { transpose_item(INP(13), 2048, 1024, WSB(WS_WO), 0, nullptr, 0, r, lane); continue; } r -= I_O;
                if (r < I_UP) { transpose_item(INP(15), 1024, NUP, WSB(WS_UP0), 0, INP(14), 2, r, lane); continue; } r -= I_UP;
                if (r < I_UP) { transpose_item(INP(15) + (size_t)1024 * NUP, 1024, NUP, WSB(WS_UP1), 0, INP(14) + 1024, 2, r, lane); continue; } r -= I_UP;
                if (r < I_DN) { transpose_item(INP(17), DFF, 1024, WSB(WS_DN0), 0, nullptr, 0, r, lane); continue; } r -= I_DN;
                transpose_item(INP(17) + (size_t)DFF * 1024, DFF, 1024, WSB(WS_DN1), 0, nullptr, 0, r, lane);
            }
            float* COS = WSF(WS_COS); float* SIN = WSF(WS_SIN);
            for (int i = vcu * 512 + tid; i < SEQ * 128; i += G * 512) {
                const int pos = i >> 7, k = i & 127; const float irx = INV_REV[2 * k], iry = INV_REV[2 * k + 1]; const float fp = (float)pos;
                const float ph = fp * irx, pe = __builtin_fmaf(fp, irx, -ph) + fp * iry;
                const float rev = (ph - __builtin_floorf(ph)) + pe;
                COS[i] = __builtin_amdgcn_cosf(rev); SIN[i] = __builtin_amdgcn_sinf(rev);
            }
        }
        { const float* x = INP(0); bf16* XB = WSB(WS_XB); float* SSQ = WSF(WS_SSQ);
        for (int m = half * pg8::MH + 4 * gw; m < (half + 1) * pg8::MH; m += 4 * NGW) {
            const f32x4* xr = (const f32x4*)(x + (size_t)m * DM) + lane; float sq[4] = {0.f, 0.f, 0.f, 0.f};
            unsigned long long* o8 = (unsigned long long*)(XB + (size_t)m * DM) + lane;
            f32x4 v[16];
#pragma unroll
            for (int j = 0; j < 16; ++j) v[j] = xr[64 * j];
#pragma unroll
            for (int j = 0; j < 16; ++j) { sq[j >> 2] += (v[j][0] * v[j][0] + v[j][1] * v[j][1]) + (v[j][2] * v[j][2] + v[j][3] * v[j][3]);
                o8[64 * j] = (unsigned long long)cvt_pk_bf16(v[j][0], v[j][1]) | ((unsigned long long)cvt_pk_bf16(v[j][2], v[j][3]) << 32); }
#pragma unroll
            for (int r = 0; r < 4; ++r) sq[r] = wave_sum(sq[r]);
            if (lane < 16) SSQ[(size_t)m * 4 + lane] = (lane == 0) ? sq[0] : (lane == 4) ? sq[1] : (lane == 8) ? sq[2] : (lane == 12) ? sq[3] : 0.f;
        } }
    }
    asm volatile("s_waitcnt vmcnt(0)" ::: "memory");
    __syncthreads();
    cooperative_groups::this_grid().sync();
    if (tid0 == 0) { __builtin_amdgcn_fence(__ATOMIC_ACQUIRE, "agent"); asm volatile("s_waitcnt vmcnt(0)" ::: "memory"); }
    __syncthreads();
    const Events ev = events_post((unsigned*)(args.ws + WS_CTL), MISC + 8);
    if (tid0 == 128) { unsigned nloc_, nx_; events_census(ev.ctl, ev.x, nloc_, nx_); ev.st[0] = nloc_; ev.st[1] = nx_; }
    {
        FRESH;
        pg8::Gemm g{WSB(WS_XB), WSB(WS_WIN), M_TOK, 3072, 1024}; PairOrder S; S.init(3072, G, bx, 0, ev, EV(1, 0), -1);
        pg8::EpiProj E{RA(RO_PROJ), HDB(1024) / 2, WSF(WS_SSQ), INP(3), INP(4), (LAS float*)(lds + XCH_OFF)};
        pg8::gemm_phase<pg8::EpiProj, PairOrder, true, true>(lds + RING_OFF, g, S, E);
        if (S.nA == 0) ev_step(ev, EV(1, 0), -1);
        ev_step(ev, EV(1, 1), EV(1, 0));
    }
#pragma unroll 1
    for (int half = 0; half < 2; ++half) {
        ENTER(2); FRESH;
        bf16* PROJ = HB(RO_PROJ, 1024); bf16* OP = HB(RO_OP, 1024); float* LSE = WSF(WS_LSE);
        const int per = (3 * 1024 + G - 1) / G; int n = 3 * 1024 - vcu * per; n = n < 0 ? 0 : (n > per ? per : n);
        att::attn_units(lds + RING_OFF, PROJ, PROJ + PSZ, PROJ + 2 * PSZ, OP, LSE, vcu * per, n, half);
        LEAVE(2);
    }
#pragma unroll 1
    for (int half = 0; half < 2; ++half) {
        ENTER(3); FRESH;
        bf16* PROJ = HB(RO_PROJ, 1024);
        merge_sconv_phase(bx * 512 + tid, G * 512, HB(RO_OP, 1024), WSF(WS_LSE), PROJ + 3 * PSZ, PROJ + 4 * PSZ, INP(5), HB(RO_AB, 2048), half);
        LEAVE(3);
    }
    {
        FRESH;
        pg8::Gemm g{RA(RO_AB), WSB(WS_WOUT), M_TOK, 1024, 1024}; PairOrder S; S.init(1024, G, bx, HDB(2048), ev, EV(4, 0), EV(3, 1));
        pg8::EpiRes<false> E{A_->out, WSB(WS_XB), WSF(WS_SSQ), (LAS float*)(lds + XCH_OFF)};
        pg8::gemm_phase<pg8::EpiRes<false>, PairOrder, true, true>(lds + RING_OFF, g, S, E);
        if (S.nA == 0) ev_step(ev, EV(4, 0), -1);
        ev_step(ev, EV(4, 1), EV(4, 0));
    }
#define FFN_UP(pu, l) \
    { \
        FRESH; \
        pg8::Gemm g{WSB(WS_XB), WSB((l) ? WS_UP1 : WS_UP0), M_TOK, NUP, 1024}; PairOrder S; S.init(NUP, G, bx, 0, ev, EV(pu, 0), EV((pu) - 1, 1)); \
        pg8::EpiUp E{RA(RO_HID), HDB(2 * DFF) / 2, WSF(WS_SSQ), INP(16) + (size_t)(l) * 3 * NUP, WSF(WS_UF), WSF(WS_UL), (LAS float*)(lds + XCH_OFF)}; \
        pg8::gemm_phase<pg8::EpiUp, PairOrder, true, true>(lds + RING_OFF, g, S, E); \
        if (S.nA == 0) ev_step(ev, EV(pu, 0), -1); \
        ev_step(ev, EV(pu, 1), EV(pu, 0)); \
    }
#define FFN_DOWN(pd, l, LASTF) \
    _Pragma("unroll 1") for (int half = 0; half < 2; ++half) { \
        ENTER(pd); FRESH; \
        pg8::Gemm g{HB(RO_HID, 2 * DFF), WSB((l) ? WS_DN1 : WS_DN0), M_TOK, 1024, DFF}; pg8::HalfOrder S; S.init(1024, G, bx, half); \
        { const int en_ = (LASTF) ? (half == 0 ? EV((pd) - 1, 1) : -1) : (half == 0 ? EV((pd) - 1, 1) : EV(pd, 0)); if (en_ >= 0) S.set_early((const unsigned*)(ws + WS_CTL) + EV_DONE(en_), MISC + 13, (unsigned)(en_ + 1)); } \
        { pg8::Unit u; for (int i = 0; S.next(i, u); ++i) fixup_rows(u.pm, WSF(WS_UF), WSF(WS_UL), INP(16) + (size_t)(l) * 3 * NUP, HB(RO_HID, 2 * DFF), tid); } \
        VM_WAIT(); __syncthreads(); \
        pg8::EpiRes<LASTF> E{A_->out, WSB(WS_XB), WSF(WS_SSQ), (LAS float*)(lds + XCH_OFF)}; \
        pg8::gemm_phase<pg8::EpiRes<LASTF>, pg8::HalfOrder, true, true>(lds + RING_OFF, g, S, E); \
        if (!(LASTF)) LEAVE(pd); else if (half == 0) ev_step(ev, -1, EV((pd) - 1, 1)); \
    }
    FFN_UP(5, 0)
    FFN_DOWN(6, 0, false)
    {
        FRESH;
        pg8::Gemm g{WSB(WS_XB), WSB(WS_WQKV), M_TOK, 4096, 1024}; PairOrder S; S.init(4096, G, bx, 0, ev, EV(7, 0), EV(6, 1));
        pg8::EpiQKV E{RA(RO_Q1), RA(RO_K1), RA(RO_V1), HDB(2048) / 2, HDB(4096) / 2, WSF(WS_SSQ), WSF(WS_COS), WSF(WS_SIN), (LAS float*)(lds + XCH_OFF)};
        pg8::gemm_phase<pg8::EpiQKV, PairOrder, true, true>(lds + RING_OFF, g, S, E);
        if (S.nA == 0) ev_step(ev, EV(7, 0), -1);
        ev_step(ev, EV(7, 1), EV(7, 0));
    }
#pragma unroll 1
    for (int half = 0; half < 2; ++half) {
        ENTER(8); FRESH;
        bf16* PS = (bf16*)(ws + WS_R + (size_t)half * HALF_REGION + RO_PS) - (size_t)half * 512 * 16384;
        for (int pr = half * 256 + vcu; pr < (half + 1) * 256; pr += G) ret::score_pair(lds + RING_OFF, HB(RO_Q1, 2048), HB(RO_K1, 2048), PS, pr);
        bool mine0 = false; for (int it = vcu; it < 256; it += G) mine0 |= (it >> 7) == 0;
        ev_step(ev, EV(8, half), half == 0 ? EV(7, 1) : (mine0 ? EV(8, 0) : -1));
    }
#pragma unroll 1
    for (int half = 0; half < 2; ++half) {
        for (int it = vcu; it < 256; it += G) {
            if ((it >> 7) != half) continue;
            FRESH;
            bf16* PS = (bf16*)(ws + WS_R + (size_t)half * HALF_REGION + RO_PS) - (size_t)half * 512 * 16384;
            ret::ret_item(lds + RING_OFF, HB(RO_Q1, 2048), HB(RO_K1, 2048), HB(RO_V1, 4096), PS, WSF(WS_GNS), it);
        }
        bool mine1 = false; for (int it = vcu; it < 256; it += G) mine1 |= (it >> 7) == 1;
        ev_step(ev, EV(9, half), half == 0 ? (mine1 ? EV(8, 1) : -1) : EV(9, 0));
    }
#pragma unroll 1
    for (int half = 0; half < 2; ++half) {
        ENTER(10); FRESH;
        pg8::Gemm g{WSB(WS_XB), WSB(WS_WG), M_TOK, 2048, 1024}; pg8::HalfOrder S; S.init(2048, G, bx, half);
        { const int en_ = half == 0 ? EV(9, 1) : EV(10, 0); S.set_early((const unsigned*)(ws + WS_CTL) + EV_DONE(en_), MISC + 13, (unsigned)(en_ + 1)); }
        { pg8::Unit u; for (int i = 0; S.next(i, u); ++i) gn_stats_rows(u.pm, u.pn >> 1, WSF(WS_GNS), WSF(WS_MR), tid); }
        VM_WAIT(); __syncthreads();
        pg8::EpiGate E{HB(RO_V1, 4096), WSF(WS_SSQ), WSF(WS_MR), INP(12), (LAS float*)(lds + XCH_OFF)};
        pg8::gemm_phase<pg8::EpiGate, pg8::HalfOrder, true, true>(lds + RING_OFF, g, S, E);
        LEAVE(10);
    }
    {
        FRESH;
        pg8::Gemm g{RA(RO_V1), WSB(WS_WO), M_TOK, 1024, 2048}; PairOrder S; S.init(1024, G, bx, HDB(4096), ev, EV(11, 0), EV(10, 1));
        pg8::EpiRes<false> E{A_->out, WSB(WS_XB), WSF(WS_SSQ), (LAS float*)(lds + XCH_OFF)};
        pg8::gemm_phase<pg8::EpiRes<false>, PairOrder, true, true>(lds + RING_OFF, g, S, E);
        if (S.nA == 0) ev_step(ev, EV(11, 0), -1);
        ev_step(ev, EV(11, 1), EV(11, 0));
    }
    FFN_UP(12, 1)
    FFN_DOWN(13, 1, true)
#undef FFN_UP
#undef FFN_DOWN
#undef FRESH
#undef INP
#undef WSF
#undef WSB
#undef HB
#undef RA
#undef HDB
#undef EV
#undef ENTER
#undef LEAVE
}

extern "C" void kernel_launch(void* const* d_in, const int* in_sizes, int n_in, void* d_out, int out_size, void* d_ws, size_t ws_size, hipStream_t stream) {
    static int grid = 0;
    if (grid == 0) {
        if (n_in != 18 || in_sizes[0] != M_TOK * DM || out_size != M_TOK * DM || ws_size < WS_END) {
            fprintf(stderr, "kernel_launch: unexpected problem (n_in %d, in0 %d, out %d, ws %zu, need %zu)\n", n_in, n_in > 0 ? in_sizes[0] : -1, out_size, ws_size, (size_t)WS_END); grid = -1; return; }
        int dev = 0, cus = 0, per_cu = 0;
        if (hipGetDevice(&dev) != hipSuccess || hipDeviceGetAttribute(&cus, hipDeviceAttributeMultiprocessorCount, dev) != hipSuccess) { grid = -1; return; }
        if (hipFuncSetAttribute((const void*)trunk_fwd, hipFuncAttributeMaxDynamicSharedMemorySize, LDS_BYTES) != hipSuccess) { fprintf(stderr, "kernel_launch: hipFuncSetAttribute failed\n"); grid = -1; return; }
        if (hipOccupancyMaxActiveBlocksPerMultiprocessor(&per_cu, (const void*)trunk_fwd, NWAVES * 64, LDS_BYTES) != hipSuccess || per_cu < 1) { fprintf(stderr, "kernel_launch: occupancy query says %d\n", per_cu); grid = -1; (void)hipGetLastError(); return; }
        grid = cus * (per_cu < 1 ? per_cu : 1);
    }
    if (grid < 0) return;
    Args a{};
    for (int i = 0; i < 18; ++i) a.in[i] = (const float*)d_in[i];
    a.out = (float*)d_out; a.ws = (unsigned char*)d_ws;
    void* kargs[] = {&a};
    hipError_t e = hipLaunchCooperativeKernel((const void*)trunk_fwd, dim3(grid), dim3(NWAVES * 64), kargs, LDS_BYTES, stream);
    if (e != hipSuccess) fprintf(stderr, "kernel_launch: cooperative launch failed: %s (grid %d)\n", hipGetErrorString(e), grid);
}
```

```cpp
#include <hip/hip_runtime.h>
#include <cstdio>
#include <cstdint>

constexpr int M_TOK = 32768, SEQ = 4096, DM = 1024;
constexpr int DFF = 2816, NUP = 2 * DFF;
constexpr float EPS = 1e-6f;
constexpr float LOG2E = 1.4426950408889634f;
constexpr float QSCALE = 0.125f * LOG2E;

#define LAS __attribute__((address_space(3)))
__device__ __forceinline__ int tidx_opaque() { int t_ = threadIdx.x; asm volatile("" : "+v"(t_)); return t_ & 511; }
#define TIDX() tidx_opaque()
#define GAS __attribute__((address_space(1)))

#ifndef RELAX_RES
#define RELAX_RES false
#endif
#ifndef RELAX_UP
#define RELAX_UP false
#endif
#ifndef RELAX_QKV
#define RELAX_QKV false
#endif
#ifndef RELAX_GATE
#define RELAX_GATE false
#endif
namespace pg8 {
#define PG8_LAS __attribute__((address_space(3)))
typedef unsigned short bf16_t;
typedef short bf16x8 __attribute__((ext_vector_type(8)));
typedef float f32x4 __attribute__((ext_vector_type(4)));
typedef unsigned u32x4 __attribute__((ext_vector_type(4)));
typedef unsigned u32x2 __attribute__((ext_vector_type(2)));
constexpr int BM = 256, BK = 64, HALF = 128, HTB = HALF * BK * 2  , STAGE_BYTES = 8 * HTB, NXCD = 8, WGM = 4;

__host__ __device__ __forceinline__ int lds_byte(int r, int c) { const int st = (r >> 4) * 2 + (c >> 5), rr = r & 15, cc = c & 31, ob = rr * 64 + cc * 2; return st * 1024 + (ob ^ (((ob >> 9) & 1) << 5)); }
__host__ __device__ __forceinline__ void stage_rc(int b, int& R, int& C) { const int st = b / 1024, sb = b % 1024, swz = sb ^ (((sb >> 9) & 1) << 5); R = (st >> 1) * 16 + swz / 64; C = (st & 1) * 32 + (swz % 64) / 2; }
__host__ __device__ __forceinline__ int perm32(int rho) { const int n = rho >> 4, i = rho & 15; return 8 * (i >> 2) + 4 * n + (i & 3); }

struct Unit { int pm, pn; };
struct Gemm { const bf16_t* A; const bf16_t* Bt; int M, N, K; };

struct StaticOrder {
    int nM, nN, nwg, G, c;
    __host__ __device__ __forceinline__ void init(int M, int N, int G_, int c_) { nM = M / BM; nN = N / BM; nwg = nM * nN; G = G_; c = c_; }
    __host__ __device__ __forceinline__ bool next(int i, Unit& u) const {
        const long L = (long)i * G + c; if (L >= nwg) return false;
        int wgid = (int)L; { const int q = nwg / NXCD, r = nwg % NXCD, xcd = wgid % NXCD, off = wgid / NXCD; wgid = (xcd < r ? xcd * (q + 1) : r * (q + 1) + (xcd - r) * q) + off; }
        const int nig = WGM * nN, gid = wgid / nig, fm = gid * WGM, gsz = (nM % WGM == 0) ? WGM : ((nM - fm) < WGM ? (nM - fm) : WGM);
        u.pm = fm + ((wgid % nig) % gsz); u.pn = (wgid % nig) / gsz; return true;
    }
    __device__ __forceinline__ void a_ready(const Unit&) const {}
    __device__ __forceinline__ void done(const Unit&) const {}
};

constexpr int MH = 16384;
__device__ __forceinline__ void ev_early_acquire(const unsigned* done_word, volatile LAS unsigned* flag, unsigned tag) {
    if (done_word == nullptr) return;
    const int t = TIDX();
    if (__builtin_amdgcn_readfirstlane(t >> 6) == 1) {
        unsigned d;
        asm volatile("s_load_dword %0, %1, 0x0 glc\n\ts_waitcnt lgkmcnt(0)" : "=s"(d) : "s"(done_word) : "memory");
        if (d != 0u) { asm volatile("buffer_inv sc1" ::: "memory"); if (t == 64) *flag = tag; }
    }
}
struct HalfOrder {
    StaticOrder so; int pm_off; const unsigned* e_word; volatile LAS unsigned* e_flag; unsigned e_tag;
    __device__ __forceinline__ void init(int N, int G, int c, int half) { so.init(MH, N, G, half ? G - 1 - c : c); pm_off = half * (MH / BM); e_word = nullptr; e_flag = nullptr; e_tag = 0u; }
    __device__ __forceinline__ void set_early(const unsigned* w, volatile LAS unsigned* f, unsigned tag) { e_word = w; e_flag = f; e_tag = tag; }
    __device__ __forceinline__ void early() const { ev_early_acquire(e_word, e_flag, e_tag); }
    __device__ __forceinline__ bool next(int i, Unit& u) const { if (!so.next(i, u)) return false; u.pm += pm_off; return true; }
    __device__ __forceinline__ void a_ready(const Unit&, int) const {}
    __device__ __forceinline__ void done(const Unit&, int) const {}
    __device__ __forceinline__ size_t a_off(const Unit&) const { return 0; }
};

typedef float f32x2_t __attribute__((ext_vector_type(2))); typedef __bf16 bf16x2_t __attribute__((ext_vector_type(2)));
__device__ __forceinline__ unsigned cvt_pk_bf16(float lo, float hi) { f32x2_t v = {lo, hi}; bf16x2_t b = __builtin_convertvector(v, bf16x2_t); return __builtin_bit_cast(unsigned, b); }
__device__ __forceinline__ float bflo(unsigned w) { return __uint_as_float(w << 16); }
__device__ __forceinline__ float bfhi(unsigned w) { return __uint_as_float(w & 0xffff0000u); }
__device__ __forceinline__ float xor16_32_sum(float s) { s += __shfl_xor(s, 16); s += __shfl_xor(s, 32); return s; }
__device__ __forceinline__ float silu_f(float x) { return x * __builtin_amdgcn_rcpf(1.0f + __builtin_amdgcn_exp2f(-x * LOG2E)); }

constexpr int XO_RS = 2048, XO_CW = 4096, XO_GN = 5632;
#define EPI_BAR() do { asm volatile("s_waitcnt lgkmcnt(0)" ::: "memory"); __builtin_amdgcn_s_barrier(); asm volatile("" ::: "memory"); } while (0)
__device__ __forceinline__ void rs_prefetch(const float* ssq, const Unit& u, LAS float* xch, int ui) {
    const int wid = __builtin_amdgcn_readfirstlane(TIDX() >> 6), lane = TIDX() & 63;
    if (wid < 4) __builtin_amdgcn_global_load_lds((const unsigned*)(ssq + (size_t)(u.pm * BM + 64 * wid + lane) * 4), (LAS unsigned*)(xch + XO_RS + (ui & 1) * 1024 + 64 * wid * 4), 16, 0, 0);
}
__device__ __forceinline__ float rs_row(const LAS float* xch, int ui, int row) {
    const f32x4 a = *(const LAS f32x4*)(xch + XO_RS + (ui & 1) * 1024 + row * 4);
    return __builtin_amdgcn_rsqf(((a[0] + a[1]) + (a[2] + a[3])) * (1.0f / 1024.0f) + EPS);
}
__device__ __forceinline__ void rs_read(const LAS float* xch, int ui, int wr, int fr, float (&rs)[2][4]) {
#pragma unroll
    for (int ai = 0; ai < 2; ++ai)
#pragma unroll
        for (int m = 0; m < 4; ++m) rs[ai][m] = rs_row(xch, ui, ai * HALF + wr * 64 + m * 16 + fr);
}

struct EpiProj {
    static constexpr bool PERM = true, AFTER_DRAIN = false, AROWPERM = false, FUSED_INIT = false; static constexpr int NSTORE = 8; static constexpr bool RELAX_FIRST = true;
    struct Init {};
    __device__ __forceinline__ void init_load(Init&, const Unit&, int, int, int, int) const {}
    __device__ __forceinline__ void init_acc(const Init&, f32x4 (&acc)[2][2][4][2]) const {
#pragma unroll
        for (int a = 0; a < 2; ++a)
#pragma unroll
            for (int b = 0; b < 2; ++b)
#pragma unroll
                for (int m = 0; m < 4; ++m)
#pragma unroll
                    for (int n = 0; n < 2; ++n) acc[a][b][m][n] = (f32x4){0.f, 0.f, 0.f, 0.f};
    }
    bf16_t* out; size_t hd; const float* ssq; const float* qg; const float* kg; LAS float* xch;
    __device__ __forceinline__ void prefetch(const Unit& u, int ui) const {
        rs_prefetch(ssq, u, xch, ui);
        const int wid = __builtin_amdgcn_readfirstlane(TIDX() >> 6), lane = TIDX() & 63;
        if (wid == 4) __builtin_amdgcn_global_load_lds((const unsigned*)(qg + lane), (LAS unsigned*)(xch + XO_GN), 4, 0, 0);
        if (wid == 5) __builtin_amdgcn_global_load_lds((const unsigned*)(kg + lane), (LAS unsigned*)(xch + XO_GN + 64), 4, 0, 0);
    }
    __device__ __forceinline__ void operator()(const f32x4 (&acc)[2][2][4][2], const Unit& u, int wr, int wc, int fr, int fq, int ui) const {
        asm volatile("" : "+v"(fr), "+v"(fq));
        const int row0 = u.pm * BM + wr * 64 + fr;
        float rs[2][4]; rs_read(xch, ui, wr, fr, rs);
        const int t = u.pn >> 1, cbase = (u.pn & 1) * 256 + wc * 64 + 8 * fq;
        bf16_t* const outh = out + ((u.pm >= MH / BM) ? hd : (size_t)0);
        bf16_t* base = outh + (size_t)t * ((size_t)MH * 512);
        if (t < 2) {
            const LAS float* gn = xch + XO_GN + (t == 0 ? 0 : 64); const float sc = (t == 0) ? QSCALE : 1.0f;
            f32x4 gv[2][2];
#pragma unroll
            for (int bj = 0; bj < 2; ++bj)
#pragma unroll
                for (int n = 0; n < 2; ++n) gv[bj][n] = *(const LAS f32x4*)(gn + 32 * bj + 8 * fq + 4 * n);
#pragma unroll
            for (int ai = 0; ai < 2; ++ai)
#pragma unroll
                for (int m = 0; m < 4; ++m) {
                    f32x4 v[2][2]; float ss = 0.f;
#pragma unroll
                    for (int bj = 0; bj < 2; ++bj)
#pragma unroll
                        for (int n = 0; n < 2; ++n) { v[bj][n] = acc[ai][bj][m][n] * rs[ai][m]; const f32x4 x = v[bj][n]; ss += (x[0] * x[0] + x[1] * x[1]) + (x[2] * x[2] + x[3] * x[3]); }
                    ss = xor16_32_sum(ss);
                    const float r = __builtin_amdgcn_rsqf(ss * (1.0f / 64.0f) + EPS) * sc;
                    bf16_t* rowp = base + (size_t)(row0 + ai * HALF + m * 16) * 512 + cbase;
#pragma unroll
                    for (int bj = 0; bj < 2; ++bj) { const f32x4 a = v[bj][0] * gv[bj][0] * r, b = v[bj][1] * gv[bj][1] * r;
                        u32x4 w; w.x = cvt_pk_bf16(a[0], a[1]); w.y = cvt_pk_bf16(a[2], a[3]); w.z = cvt_pk_bf16(b[0], b[1]); w.w = cvt_pk_bf16(b[2], b[3]);
                        *(u32x4*)(rowp + 32 * bj) = w; }
                }
        } else if (u.pn >= 8) {
            bf16_t* pb = outh + (size_t)4 * ((size_t)MH * 512) + (u.pn - 8) * 128 + wc * 32 + 8 * fq;
#pragma unroll
            for (int ai = 0; ai < 2; ++ai)
#pragma unroll
                for (int m = 0; m < 4; ++m) { const float r2 = rs[ai][m] * rs[ai][m];
                    const f32x4 a = acc[ai][0][m][0] * acc[ai][1][m][0] * r2, b = acc[ai][0][m][1] * acc[ai][1][m][1] * r2;
                    u32x4 w; w.x = cvt_pk_bf16(a[0], a[1]); w.y = cvt_pk_bf16(a[2], a[3]); w.z = cvt_pk_bf16(b[0], b[1]); w.w = cvt_pk_bf16(b[2], b[3]);
                    *(u32x4*)(pb + (size_t)(row0 + ai * HALF + m * 16) * 512) = w; }
        } else {
#pragma unroll
            for (int ai = 0; ai < 2; ++ai)
#pragma unroll
                for (int m = 0; m < 4; ++m) {
                    bf16_t* rowp = base + (size_t)(row0 + ai * HALF + m * 16) * 512 + cbase;
#pragma unroll
                    for (int bj = 0; bj < 2; ++bj) { const f32x4 a = acc[ai][bj][m][0] * rs[ai][m], b = acc[ai][bj][m][1] * rs[ai][m];
                        u32x4 w; w.x = cvt_pk_bf16(a[0], a[1]); w.y = cvt_pk_bf16(a[2], a[3]); w.z = cvt_pk_bf16(b[0], b[1]); w.w = cvt_pk_bf16(b[2], b[3]);
                        *(u32x4*)(rowp + 32 * bj) = w; }
                }
        }
    }
};

template <bool LAST> struct EpiRes {
    static constexpr bool PERM = true, AFTER_DRAIN = false, AROWPERM = false, FUSED_INIT = true; static constexpr int NSTORE = 16; static constexpr bool RELAX_FIRST = RELAX_RES;
    float* out; bf16_t* xb; float* ssq; LAS float* xch;
    __device__ __forceinline__ void prefetch(const Unit&, int) const {}
    struct Init { u32x4 rv[2][4][2]; };
    __device__ __forceinline__ void init_load(Init& I, const Unit& u, int wr, int wc, int fr, int fq) const {
        const bf16_t* p = xb + (size_t)(u.pm * BM + wr * 64 + fr) * DM + u.pn * BM + wc * 32 + 8 * fq;
#pragma unroll
        for (int ai = 0; ai < 2; ++ai)
#pragma unroll
            for (int m = 0; m < 4; ++m)
#pragma unroll
                for (int bj = 0; bj < 2; ++bj) I.rv[ai][m][bj] = *(const u32x4*)(p + (size_t)(ai * HALF + m * 16) * DM + bj * HALF);
    }
    __device__ __forceinline__ void init_acc(const Init& I, f32x4 (&acc)[2][2][4][2]) const {
#pragma unroll
        for (int ai = 0; ai < 2; ++ai)
#pragma unroll
            for (int m = 0; m < 4; ++m)
#pragma unroll
                for (int bj = 0; bj < 2; ++bj) { const u32x4 r = I.rv[ai][m][bj];
                    acc[ai][bj][m][0] = (f32x4){bflo(r.x), bfhi(r.x), bflo(r.y), bfhi(r.y)}; acc[ai][bj][m][1] = (f32x4){bflo(r.z), bfhi(r.z), bflo(r.w), bfhi(r.w)}; }
    }
    __device__ __forceinline__ void fused(f32x4 (&acc)[2][2][4][2], const Unit& u, const Unit& un, bool has_next, int wr, int wc, int fr, int fq, int) const {
        asm volatile("" : "+v"(fr), "+v"(fq));
        const int row0 = u.pm * BM + wr * 64 + fr, col0 = u.pn * BM + wc * 32 + 8 * fq;
        const bf16_t* pn = xb + (size_t)(un.pm * BM + wr * 64 + fr) * DM + un.pn * BM + wc * 32 + 8 * fq;
#pragma unroll
        for (int ai = 0; ai < 2; ++ai) {
            u32x4 rv[4][2];
            if (has_next) {
#pragma unroll
                for (int m = 0; m < 4; ++m)
#pragma unroll
                    for (int bj = 0; bj < 2; ++bj) rv[m][bj] = *(const u32x4*)(pn + (size_t)(ai * HALF + m * 16) * DM + bj * HALF);
            }
            asm volatile("" ::: "memory");
#pragma unroll
            for (int m = 0; m < 4; ++m) {
                const int row = row0 + ai * HALF + m * 16; const size_t off = (size_t)row * DM + col0; float s = 0.f;
#pragma unroll
                for (int bj = 0; bj < 2; ++bj) {
                    const f32x4 o0 = acc[ai][bj][m][0], o1 = acc[ai][bj][m][1];
                    if (LAST) { *(f32x4*)(out + off + bj * HALF) = o0; *(f32x4*)(out + off + bj * HALF + 4) = o1; }
                    else { u32x4 w; w.x = cvt_pk_bf16(o0[0], o0[1]); w.y = cvt_pk_bf16(o0[2], o0[3]); w.z = cvt_pk_bf16(o1[0], o1[1]); w.w = cvt_pk_bf16(o1[2], o1[3]);
                        *(u32x4*)(xb + off + bj * HALF) = w;
                        const float r0 = bflo(w.x), r1 = bfhi(w.x), r2 = bflo(w.y), r3 = bfhi(w.y), r4 = bflo(w.z), r5 = bfhi(w.z), r6 = bflo(w.w), r7 = bfhi(w.w);
                        s += ((r0 * r0 + r1 * r1) + (r2 * r2 + r3 * r3)) + ((r4 * r4 + r5 * r5) + (r6 * r6 + r7 * r7)); }
                }
                if (!LAST) { s = xor16_32_sum(s); if (fq == 0) xch[(ai * HALF + wr * 64 + m * 16 + fr) * 4 + wc] = s; }
            }
            asm volatile("" ::: "memory");
            if (has_next) {
#pragma unroll
                for (int m = 0; m < 4; ++m)
#pragma unroll
                    for (int bj = 0; bj < 2; ++bj) { const u32x4 r = rv[m][bj];
                        acc[ai][bj][m][0] = (f32x4){bflo(r.x), bfhi(r.x), bflo(r.y), bfhi(r.y)}; acc[ai][bj][m][1] = (f32x4){bflo(r.z), bfhi(r.z), bflo(r.w), bfhi(r.w)}; }
            }
        }
        if (!LAST) {
            EPI_BAR();
            const int t = TIDX();
            if (t < 256) { const f32x4 v = *(const LAS f32x4*)(xch + t * 4); ssq[(size_t)(u.pm * BM + t) * 4 + u.pn] = (v[0] + v[1]) + (v[2] + v[3]); }
        }
    }
};

__device__ __forceinline__ float dpp_shr1(float old, float src) { return __builtin_bit_cast(float, __builtin_amdgcn_update_dpp(__builtin_bit_cast(int, old), __builtin_bit_cast(int, src), 0x111, 0xF, 0xF, false)); }

struct EpiUp {
    static constexpr bool PERM = true, AFTER_DRAIN = false, AROWPERM = true, FUSED_INIT = false; static constexpr int NSTORE = 16; static constexpr bool RELAX_FIRST = RELAX_UP;
    struct Init {};
    __device__ __forceinline__ void init_load(Init&, const Unit&, int, int, int, int) const {}
    __device__ __forceinline__ void init_acc(const Init&, f32x4 (&acc)[2][2][4][2]) const {
#pragma unroll
        for (int a = 0; a < 2; ++a)
#pragma unroll
            for (int b = 0; b < 2; ++b)
#pragma unroll
                for (int m = 0; m < 4; ++m)
#pragma unroll
                    for (int n = 0; n < 2; ++n) acc[a][b][m][n] = (f32x4){0.f, 0.f, 0.f, 0.f};
    }
    bf16_t* hid; size_t hd; const float* ssq; const float* cw; float* uf; float* ul; LAS float* xch;
    __device__ __forceinline__ void prefetch(const Unit& u, int ui) const {
        rs_prefetch(ssq, u, xch, ui);
        const int wid = __builtin_amdgcn_readfirstlane(TIDX() >> 6), lane = TIDX() & 63;
        if (wid >= 4 && wid < 7) { const int k = wid - 4, col = lane * 4, bj = col >> 7, i = col & 127;
            __builtin_amdgcn_global_load_lds((const unsigned*)(cw + (size_t)k * NUP + bj * DFF + u.pn * 128 + i), (LAS unsigned*)(xch + XO_CW + (ui & 1) * 768 + k * 256), 16, 0, 0); }
    }
    __device__ __forceinline__ void operator()(const f32x4 (&acc)[2][2][4][2], const Unit& u, int wr, int wc, int fr, int fq, int ui) const {
        asm volatile("" : "+v"(fr), "+v"(fq));
        const int row0 = u.pm * BM + wr * 64 + 4 * fr;
        bf16_t* const hidh = hid + ((u.pm >= MH / BM) ? hd : (size_t)0);
        const LAS float* cwl = xch + XO_CW + (ui & 1) * 768;
        float rs[2][4];
#pragma unroll
        for (int ai = 0; ai < 2; ++ai)
#pragma unroll
            for (int m = 0; m < 4; ++m) rs[ai][m] = rs_row(xch, ui, ai * HALF + wr * 64 + 4 * fr + m);
        const int colw = 32 * wc + 8 * fq;
        if (fr == 15) {
#pragma unroll
            for (int ai = 0; ai < 2; ++ai)
#pragma unroll
                for (int e = 0; e < 2; ++e)
#pragma unroll
                    for (int bj = 0; bj < 2; ++bj)
#pragma unroll
                        for (int n = 0; n < 2; ++n) {
                            const f32x4 v = acc[ai][bj][2 + e][n] * rs[ai][2 + e];
                            *(LAS f32x4*)(xch + ((2 * ai + wr) * 2 + e) * 256 + 128 * bj + colw + 4 * n) = v;
                            if (ai == 1 && wr == 1) *(f32x4*)(ul + ((size_t)u.pm * 2 + e) * NUP + u.pn * 256 + 128 * bj + colw + 4 * n) = v;
                        }
        }
        if (fr == 0 && wr == 0) {
#pragma unroll
            for (int e = 0; e < 2; ++e)
#pragma unroll
                for (int bj = 0; bj < 2; ++bj)
#pragma unroll
                    for (int n = 0; n < 2; ++n)
                        *(f32x4*)(uf + ((size_t)u.pm * 2 + e) * NUP + u.pn * 256 + 128 * bj + colw + 4 * n) = acc[0][bj][e][n] * rs[0][e];
        }
        EPI_BAR();
        const int ch0 = u.pn * 128 + colw;
#pragma unroll
        for (int n = 0; n < 2; ++n) {
            f32x4 wg[3], wv[3];
#pragma unroll
            for (int k = 0; k < 3; ++k) { wg[k] = *(const LAS f32x4*)(cwl + k * 256 + colw + 4 * n); wv[k] = *(const LAS f32x4*)(cwl + k * 256 + 128 + colw + 4 * n); }
#pragma unroll
            for (int ai = 0; ai < 2; ++ai) {
                asm volatile("" ::: "memory");
                const int q = 2 * ai + wr;
                f32x4 e1g, e2g, e1v, e2v;
                if (q == 0) { e1g = (f32x4){0.f, 0.f, 0.f, 0.f}; e2g = e1g; e1v = e1g; e2v = e1g; }
                else { const LAS float* e = xch + ((q - 1) * 2) * 256 + colw + 4 * n; e2g = *(const LAS f32x4*)e; e2v = *(const LAS f32x4*)(e + 128); e1g = *(const LAS f32x4*)(e + 256); e1v = *(const LAS f32x4*)(e + 384); }
                f32x4 cg[4], cv[4], h[4];
#pragma unroll
                for (int m = 0; m < 4; ++m) { cg[m] = acc[ai][0][m][n] * rs[ai][m]; cv[m] = acc[ai][1][m][n] * rs[ai][m]; }
#pragma unroll
                for (int j = 0; j < 4; ++j) {
                    const float g3 = dpp_shr1(e1g[j], cg[3][j]), g2 = dpp_shr1(e2g[j], cg[2][j]);
                    const float v3 = dpp_shr1(e1v[j], cv[3][j]), v2 = dpp_shr1(e2v[j], cv[2][j]);
                    const float yg0 = wg[2][j] * cg[0][j] + wg[1][j] * g3 + wg[0][j] * g2,       yv0 = wv[2][j] * cv[0][j] + wv[1][j] * v3 + wv[0][j] * v2;
                    const float yg1 = wg[2][j] * cg[1][j] + wg[1][j] * cg[0][j] + wg[0][j] * g3, yv1 = wv[2][j] * cv[1][j] + wv[1][j] * cv[0][j] + wv[0][j] * v3;
                    const float yg2 = wg[2][j] * cg[2][j] + wg[1][j] * cg[1][j] + wg[0][j] * cg[0][j], yv2 = wv[2][j] * cv[2][j] + wv[1][j] * cv[1][j] + wv[0][j] * cv[0][j];
                    const float yg3 = wg[2][j] * cg[3][j] + wg[1][j] * cg[2][j] + wg[0][j] * cg[1][j], yv3 = wv[2][j] * cv[3][j] + wv[1][j] * cv[2][j] + wv[0][j] * cv[1][j];
                    h[0][j] = silu_f(yg0) * yv0; h[1][j] = silu_f(yg1) * yv1; h[2][j] = silu_f(yg2) * yv2; h[3][j] = silu_f(yg3) * yv3;
                }
#pragma unroll
                for (int m = 0; m < 4; ++m) { u32x2 w; w.x = cvt_pk_bf16(h[m][0], h[m][1]); w.y = cvt_pk_bf16(h[m][2], h[m][3]);
                    *(u32x2*)(hidh + (size_t)(row0 + ai * HALF + m) * DFF + ch0 + 4 * n) = w; }
            }
        }
    }
};

struct EpiQKV {
    static constexpr bool PERM = true, AFTER_DRAIN = false, AROWPERM = false, FUSED_INIT = false; static constexpr int NSTORE = 16; static constexpr bool RELAX_FIRST = RELAX_QKV;
    struct Init {};
    __device__ __forceinline__ void init_load(Init&, const Unit&, int, int, int, int) const {}
    __device__ __forceinline__ void init_acc(const Init&, f32x4 (&acc)[2][2][4][2]) const {
#pragma unroll
        for (int a = 0; a < 2; ++a)
#pragma unroll
            for (int b = 0; b < 2; ++b)
#pragma unroll
                for (int m = 0; m < 4; ++m)
#pragma unroll
                    for (int n = 0; n < 2; ++n) acc[a][b][m][n] = (f32x4){0.f, 0.f, 0.f, 0.f};
    }
    bf16_t* q; bf16_t* k; bf16_t* v; size_t hdq, hdv; const float* ssq; const float* cosT; const float* sinT; LAS float* xch;
    __device__ __forceinline__ void prefetch(const Unit& u, int ui) const { rs_prefetch(ssq, u, xch, ui); }
    __device__ __forceinline__ void operator()(const f32x4 (&acc)[2][2][4][2], const Unit& u, int wr, int wc, int fr, int fq, int ui) const {
        asm volatile("" : "+v"(fr), "+v"(fq));
        const int row0 = u.pm * BM + wr * 64 + fr;
        float rs[2][4]; rs_read(xch, ui, wr, fr, rs);
        const int i0 = 32 * wc + 8 * fq;
        if (u.pn < 8) {
            bf16_t* base = ((u.pn < 4) ? q : k) + ((u.pm >= MH / BM) ? hdq : (size_t)0); const int head = u.pn & 3;
#pragma unroll
            for (int ai = 0; ai < 2; ++ai)
#pragma unroll
                for (int mp = 0; mp < 2; ++mp) {
                    f32x4 tc[2][2], ts[2][2];
#pragma unroll
                    for (int mm = 0; mm < 2; ++mm) { const int pos = (row0 + ai * HALF + (2 * mp + mm) * 16) & (SEQ - 1);
#pragma unroll
                        for (int n = 0; n < 2; ++n) { tc[mm][n] = *(const f32x4*)(cosT + (size_t)pos * 128 + i0 + 4 * n); ts[mm][n] = *(const f32x4*)(sinT + (size_t)pos * 128 + i0 + 4 * n); } }
                    asm volatile("" ::: "memory");
#pragma unroll
                    for (int mm = 0; mm < 2; ++mm) { const int m = 2 * mp + mm; const int row = row0 + ai * HALF + m * 16; const float r = rs[ai][m];
                        bf16_t* rowp = base + (size_t)row * 1024 + head * 256 + i0;
                        u32x4 w1, w2;
#pragma unroll
                        for (int n = 0; n < 2; ++n) {
                            const f32x4 x1 = acc[ai][0][m][n] * r, x2 = acc[ai][1][m][n] * r;
                            const f32x4 o1 = x1 * tc[mm][n] - x2 * ts[mm][n], o2 = x1 * ts[mm][n] + x2 * tc[mm][n];
                            if (n == 0) { w1.x = cvt_pk_bf16(o1[0], o1[1]); w1.y = cvt_pk_bf16(o1[2], o1[3]); w2.x = cvt_pk_bf16(o2[0], o2[1]); w2.y = cvt_pk_bf16(o2[2], o2[3]); }
                            else        { w1.z = cvt_pk_bf16(o1[0], o1[1]); w1.w = cvt_pk_bf16(o1[2], o1[3]); w2.z = cvt_pk_bf16(o2[0], o2[1]); w2.w = cvt_pk_bf16(o2[2], o2[3]); }
                        }
                        *(u32x4*)rowp = w1; *(u32x4*)(rowp + 128) = w2; }
                    asm volatile("" ::: "memory");
                }
        } else {
            const int c0 = (u.pn - 8) * 256 + i0;
#pragma unroll
            for (int ai = 0; ai < 2; ++ai)
#pragma unroll
                for (int m = 0; m < 4; ++m) {
                    bf16_t* rowp = v + ((u.pm >= MH / BM) ? hdv : (size_t)0) + (size_t)(row0 + ai * HALF + m * 16) * 2048 + c0;
#pragma unroll
                    for (int bj = 0; bj < 2; ++bj) { const f32x4 a = acc[ai][bj][m][0] * rs[ai][m], b = acc[ai][bj][m][1] * rs[ai][m];
                        u32x4 w; w.x = cvt_pk_bf16(a[0], a[1]); w.y = cvt_pk_bf16(a[2], a[3]); w.z = cvt_pk_bf16(b[0], b[1]); w.w = cvt_pk_bf16(b[2], b[3]);
                        *(u32x4*)(rowp + 128 * bj) = w; }
                }
        }
    }
};

struct EpiGate {
    static constexpr bool PERM = true, AFTER_DRAIN = false, AROWPERM = false, FUSED_INIT = false; static constexpr int NSTORE = 16; static constexpr bool RELAX_FIRST = RELAX_GATE;
    struct Init {};
    __device__ __forceinline__ void init_load(Init&, const Unit&, int, int, int, int) const {}
    __device__ __forceinline__ void init_acc(const Init&, f32x4 (&acc)[2][2][4][2]) const {
#pragma unroll
        for (int a = 0; a < 2; ++a)
#pragma unroll
            for (int b = 0; b < 2; ++b)
#pragma unroll
                for (int m = 0; m < 4; ++m)
#pragma unroll
                    for (int n = 0; n < 2; ++n) acc[a][b][m][n] = (f32x4){0.f, 0.f, 0.f, 0.f};
    }
    bf16_t* ro; const float* ssq; const float* mr; const float* gng; LAS float* xch;
    __device__ __forceinline__ void prefetch(const Unit& u, int ui) const {
        rs_prefetch(ssq, u, xch, ui);
        const int wid = __builtin_amdgcn_readfirstlane(TIDX() >> 6), lane = TIDX() & 63;
        if (wid == 4 || wid == 5)
            __builtin_amdgcn_global_load_lds((const unsigned*)(mr + ((size_t)(u.pn >> 1) * M_TOK + u.pm * BM + 128 * (wid - 4) + 2 * lane) * 2), (LAS unsigned*)(xch + (ui & 1) * 512 + 256 * (wid - 4)), 16, 0, 0);
    }
    __device__ __forceinline__ void operator()(const f32x4 (&acc)[2][2][4][2], const Unit& u, int wr, int wc, int fr, int fq, int ui) const {
        asm volatile("" : "+v"(fr), "+v"(fq));
        const int row0 = u.pm * BM + wr * 64 + fr;
        float rs[2][4]; rs_read(xch, ui, wr, fr, rs);
        const int c0 = u.pn * 256 + 32 * wc + 8 * fq;
        const LAS float* mrl = xch + (ui & 1) * 512;
        f32x4 gg[2][2];
#pragma unroll
        for (int bj = 0; bj < 2; ++bj)
#pragma unroll
            for (int n = 0; n < 2; ++n) gg[bj][n] = *(const f32x4*)(gng + c0 + 128 * bj + 4 * n);
#pragma unroll
        for (int ai = 0; ai < 2; ++ai) {
            u32x4 ov[4][2];
#pragma unroll
            for (int m = 0; m < 4; ++m)
#pragma unroll
                for (int bj = 0; bj < 2; ++bj) ov[m][bj] = *(const u32x4*)(ro + (size_t)(row0 + ai * HALF + m * 16) * 2048 + c0 + 128 * bj);
            asm volatile("" ::: "memory");
#pragma unroll
            for (int m = 0; m < 4; ++m) {
                const int rl = ai * HALF + wr * 64 + m * 16 + fr;
                const float mu = mrl[2 * rl], rg = mrl[2 * rl + 1];
                bf16_t* rowp = ro + (size_t)(row0 + ai * HALF + m * 16) * 2048 + c0;
#pragma unroll
                for (int bj = 0; bj < 2; ++bj) {
                    const u32x4 o4 = ov[m][bj];
                    const f32x4 g0 = acc[ai][bj][m][0] * rs[ai][m], g1 = acc[ai][bj][m][1] * rs[ai][m];
                    float o[8] = {bflo(o4.x), bfhi(o4.x), bflo(o4.y), bfhi(o4.y), bflo(o4.z), bfhi(o4.z), bflo(o4.w), bfhi(o4.w)};
                    float r[8];
#pragma unroll
                    for (int j = 0; j < 4; ++j) { r[j] = silu_f(g0[j]) * (o[j] - mu) * rg * gg[bj][0][j]; r[4 + j] = silu_f(g1[j]) * (o[4 + j] - mu) * rg * gg[bj][1][j]; }
                    u32x4 w; w.x = cvt_pk_bf16(r[0], r[1]); w.y = cvt_pk_bf16(r[2], r[3]); w.z = cvt_pk_bf16(r[4], r[5]); w.w = cvt_pk_bf16(r[6], r[7]);
                    *(u32x4*)(rowp + 128 * bj) = w;
                }
            }
            asm volatile("" ::: "memory");
        }
    }
};

template <class Epi, class Sched, bool ALIGN_EPI = false, bool SP2 = false>
__device__ __forceinline__ void gemm_phase(PG8_LAS unsigned char* lds, const Gemm g, const Sched& S, const Epi& E) {
    static_assert(Epi::NSTORE >= 8 && Epi::NSTORE <= 48, "the relaxed first-trip waits leave 8 + NSTORE operations in flight: NSTORE = the FEWEST vector-memory operations a wave issues in one epilogue");
    const int tid = TIDX(), wid = __builtin_amdgcn_readfirstlane(tid >> 6), lane = tid & 63, wr = wid >> 2, wc = wid & 3, fr = lane & 15, fq = lane >> 4;
    const int K = g.K, nt = K / BK;
    unsigned voffA[2], voffB[2];
#pragma unroll
    for (int i = 0; i < 2; ++i) { int R, C; stage_rc(tid * 16 + i * 8192, R, C); const int Rb = Epi::PERM ? ((R & ~31) + perm32(R & 31)) : R;
        const int Ra = Epi::AROWPERM ? ((R & ~63) | ((R & 15) << 2) | ((R >> 4) & 3)) : R;
        voffA[i] = (unsigned)(Ra * K + C) * 2u; voffB[i] = (unsigned)(Rb * K + C) * 2u; }
    const size_t kstep = (size_t)(BK * 2);
    const size_t hstep = (size_t)HALF * K * 2;
    const size_t tstep = 2 * hstep;
    const unsigned ldsw = (unsigned)wid * 1024u;
    const int aoff = lds_byte(wr * 64 + fr, fq * 8), boff = lds_byte(wc * 32 + fr, fq * 8);
#define PG8_SA(b, h) (((b) * 2 + (h)) * HTB)
#define PG8_SB(b, h) ((4 + (b) * 2 + (h)) * HTB)
#define PG8_STAGE(bufoff, gbase, voff) do { _Pragma("unroll") for (int _i = 0; _i < 2; ++_i) \
        __builtin_amdgcn_global_load_lds((const unsigned*)((const char*)(gbase) + (voff)[_i]), (PG8_LAS unsigned*)(lds + (bufoff) + ldsw + _i * 8192), 16, 0, 0); } while (0)
#define PG8_LDA(dst, b, h) do { _Pragma("unroll") for (int m = 0; m < 4; ++m) _Pragma("unroll") for (int k = 0; k < 2; ++k) dst[m][k] = *(const PG8_LAS bf16x8*)(lds + PG8_SA(b, h) + aoff + m * 2048 + k * 1024); } while (0)
#define PG8_LDB(dst, b, h) do { _Pragma("unroll") for (int n = 0; n < 2; ++n) _Pragma("unroll") for (int k = 0; k < 2; ++k) dst[n][k] = *(const PG8_LAS bf16x8*)(lds + PG8_SB(b, h) + boff + n * 2048 + k * 1024); } while (0)
#define PG8_MMA(ai, bj, At, Bt) do { __builtin_amdgcn_s_setprio(1); _Pragma("unroll") for (int m = 0; m < 4; ++m) _Pragma("unroll") for (int n = 0; n < 2; ++n) _Pragma("unroll") for (int k = 0; k < 2; ++k) \
        acc[ai][bj][m][n] = __builtin_amdgcn_mfma_f32_16x16x32_bf16(Bt[n][k], At[m][k], acc[ai][bj][m][n], 0, 0, 0); __builtin_amdgcn_s_setprio(0); } while (0)
#define PG8_LAUNDER asm volatile("" : "+v"(voffA[0]), "+v"(voffA[1]), "+v"(voffB[0]), "+v"(voffB[1]))
#define PG8_WAIT_V_RELAX(rx) asm volatile("s_waitcnt vmcnt(%1)\n\tv_cmp_ne_u32_e32 vcc, 0, %0\n\ts_cbranch_vccnz 1f\n\ts_waitcnt vmcnt(8)\n1:" :: "v"(rx), "n"(8 + Epi::NSTORE) : "memory", "vcc")
#define PG8_WAIT_V_FIRST2(rx) do { if constexpr (Epi::RELAX_FIRST) PG8_WAIT_V_RELAX(rx); else PG8_WAIT_V(8); } while (0)
#define PG8_WAIT_V_(n) asm volatile("s_waitcnt vmcnt(" #n ")" ::: "memory")
#define PG8_WAIT_V(n) PG8_WAIT_V_(n)
#define PG8_WAIT_L(n) asm volatile("s_waitcnt lgkmcnt(" #n ")" ::: "memory")
#define PG8_BAR __builtin_amdgcn_s_barrier()
#define PG8_SCHED __builtin_amdgcn_sched_barrier(0)
    Unit cur, nxt; int ui = 0;
    if (!S.next(0, cur)) return;
    f32x4 acc[2][2][4][2];
    bf16x8 At[4][2], B0[2][2], B1[2][2];
    const char* cA = (const char*)g.A + (size_t)cur.pm * tstep + S.a_off(cur); const char* cB = (const char*)g.Bt + (size_t)cur.pn * tstep;
    S.a_ready(cur, 0);
    typename Epi::Init ini0; E.init_load(ini0, cur, wr, wc, fr, fq);
    if constexpr (SP2) {
        PG8_LAUNDER; PG8_STAGE(PG8_SB(0, 0), cB, voffB); PG8_LAUNDER; PG8_STAGE(PG8_SB(0, 1), cB + hstep, voffB); PG8_LAUNDER; PG8_STAGE(PG8_SA(0, 0), cA, voffA); PG8_LAUNDER; PG8_STAGE(PG8_SA(0, 1), cA + hstep, voffA);
        if (wr == 1) PG8_BAR;
        PG8_WAIT_V(2); PG8_BAR;
        PG8_LAUNDER; PG8_STAGE(PG8_SB(1, 0), cB + kstep, voffB); PG8_LAUNDER; PG8_STAGE(PG8_SA(1, 0), cA + kstep, voffA); PG8_LAUNDER; PG8_STAGE(PG8_SB(1, 1), cB + hstep + kstep, voffB);
        PG8_WAIT_V(6); PG8_BAR;
    } else {
        PG8_STAGE(PG8_SB(0, 0), cB, voffB); PG8_STAGE(PG8_SA(0, 0), cA, voffA); PG8_STAGE(PG8_SB(0, 1), cB + hstep, voffB); PG8_STAGE(PG8_SA(0, 1), cA + hstep, voffA);
        if (wr == 1) PG8_BAR;
        PG8_WAIT_V(4); PG8_BAR;
        PG8_STAGE(PG8_SB(1, 0), cB + kstep, voffB); PG8_STAGE(PG8_SA(1, 0), cA + kstep, voffA); PG8_STAGE(PG8_SB(1, 1), cB + hstep + kstep, voffB);
        PG8_WAIT_V(6); PG8_BAR;
    }
    PG8_SCHED;
    E.init_acc(ini0, acc);
    for (;;) {
        E.prefetch(cur, ui);
        const bool has_next = S.next(ui + 1, nxt);
        const char* nA = has_next ? (const char*)g.A + (size_t)nxt.pm * tstep + S.a_off(nxt) : cA; const char* nB = has_next ? (const char*)g.Bt + (size_t)nxt.pn * tstep : cB;
#define PG8_TRIP(TV) do { \
            const char* a1 = cA + (size_t)(t + 1) * kstep; \
            const char* a2 = last ? nA : cA + (size_t)(t + 2) * kstep; const char* b2 = last ? nB : cB + (size_t)(t + 2) * kstep; \
            const char* a3 = a2 + kstep; const char* b3 = b2 + kstep; \
            if (last && has_next) S.a_ready(nxt, ui + 1); \
            PG8_LDB(B0, 0, 0); PG8_LDB(B1, 0, 1); PG8_SCHED; PG8_LDA(At, 0, 0); PG8_STAGE(PG8_SA(1, 1), a1 + hstep, voffA); \
            PG8_WAIT_V_FIRST2(relax); PG8_WAIT_L(0); PG8_BAR; PG8_MMA(0, 0, At, B0); PG8_MMA(0, 1, At, B1); PG8_BAR; PG8_SCHED; \
            PG8_LDA(At, 0, 1); PG8_STAGE(PG8_SB(0, 0), b2, voffB); PG8_STAGE(PG8_SB(0, 1), b2 + hstep, voffB); PG8_STAGE(PG8_SA(0, 0), a2, voffA); \
            PG8_WAIT_V_FIRST2(relax); PG8_WAIT_L(0); PG8_BAR; PG8_MMA(1, 0, At, B0); PG8_MMA(1, 1, At, B1); PG8_BAR; PG8_SCHED; \
            PG8_LDB(B0, 1, 0); PG8_LDB(B1, 1, 1); PG8_SCHED; PG8_LDA(At, 1, 0); PG8_STAGE(PG8_SA(0, 1), a2 + hstep, voffA); \
            PG8_WAIT_V(8); PG8_WAIT_L(0); PG8_BAR; PG8_MMA(0, 0, At, B0); PG8_MMA(0, 1, At, B1); PG8_BAR; PG8_SCHED; \
            PG8_LDA(At, 1, 1); PG8_STAGE(PG8_SB(1, 0), b3, voffB); PG8_STAGE(PG8_SB(1, 1), b3 + hstep, voffB); PG8_STAGE(PG8_SA(1, 0), a3, voffA); \
            PG8_WAIT_V(8); PG8_WAIT_L(0); PG8_BAR; PG8_MMA(1, 0, At, B0); PG8_MMA(1, 1, At, B1); PG8_BAR; PG8_SCHED; \
        } while (0)
        static_assert(SP2, "only the SP2 form of the K-loop is kept in this file");
        for (int t = 0; t < nt; t += 2) { const bool last = (t == nt - 2); const int relax = (Epi::RELAX_FIRST && t == 0 && ui > 0) ? 1 : 0; PG8_TRIP(t); }
#undef PG8_TRIP
        if constexpr (ALIGN_EPI) { if (wr == 0) PG8_BAR; }
        if (!has_next) S.early();

        if constexpr (Epi::FUSED_INIT) { E.fused(acc, cur, nxt, has_next, wr, wc, fr, fq, ui); S.done(cur, ui); if (!has_next) break; }
        else { E(acc, cur, wr, wc, fr, fq, ui); S.done(cur, ui); if (!has_next) break; typename Epi::Init ini; E.init_load(ini, nxt, wr, wc, fr, fq); E.init_acc(ini, acc); }
        cur = nxt; cA = nA; cB = nB; ++ui;
        if constexpr (ALIGN_EPI) { if (wr == 1) PG8_BAR; }
    }
    PG8_WAIT_V(0);
    if constexpr (!ALIGN_EPI) { if (wr == 0) PG8_BAR; }
    PG8_BAR;
    if constexpr (Epi::AFTER_DRAIN) { E.fused(acc, cur, wr, wc, fr, fq, lds, wid, lane); S.done(cur, ui); }
#undef PG8_SA
#undef PG8_SB
#undef PG8_STAGE
#undef PG8_LDA
#undef PG8_LDB
#undef PG8_MMA
#undef PG8_LAUNDER
#undef PG8_WAIT_V
#undef PG8_WAIT_V_
#undef PG8_WAIT_V_RELAX
#undef PG8_WAIT_V_FIRST2
#undef PG8_WAIT_L
#undef PG8_BAR
#undef PG8_SCHED
}
}

typedef unsigned short bf16;
typedef short bf16x8 __attribute__((ext_vector_type(8)));
typedef float f32x4 __attribute__((ext_vector_type(4)));
typedef unsigned u32x4 __attribute__((ext_vector_type(4)));
typedef unsigned u32x2 __attribute__((ext_vector_type(2)));
typedef short v4i16_t __attribute__((ext_vector_type(4)));
typedef GAS unsigned gu32;
#define RLX_AGENT __ATOMIC_RELAXED, __HIP_MEMORY_SCOPE_AGENT
#define LDS_WAIT() asm volatile("s_waitcnt lgkmcnt(0)" ::: "memory")
#define VM_WAIT() asm volatile("s_waitcnt vmcnt(0)" ::: "memory")
#define WG_BAR() do { asm volatile("s_waitcnt lgkmcnt(0)" ::: "memory"); __builtin_amdgcn_s_barrier(); asm volatile("" ::: "memory"); } while (0)
using pg8::cvt_pk_bf16; using pg8::bflo; using pg8::bfhi; using pg8::silu_f;
__device__ __forceinline__ f32x4 mfma16(bf16x8 a, bf16x8 b, f32x4 c) { return __builtin_amdgcn_mfma_f32_16x16x32_bf16(a, b, c, 0, 0, 0); }
__device__ __forceinline__ v4i16_t vtr(const LAS unsigned char* p) { return __builtin_amdgcn_ds_read_tr16_b64_v4i16((LAS v4i16_t*)p); }
__device__ __forceinline__ bf16x8 cat8(v4i16_t lo, v4i16_t hi) { return (bf16x8){lo[0], lo[1], lo[2], lo[3], hi[0], hi[1], hi[2], hi[3]}; }
__device__ __forceinline__ float wave_sum(float v) {
#pragma unroll
    for (int o = 1; o < 64; o <<= 1) v += __shfl_xor(v, o);
    return v;
}

namespace att {
constexpr int KSTR = 144;
constexpr int LDS_K = 0, LDS_V = 256 * KSTR, LDS_BYTES = 2 * 256 * KSTR;
struct UnitRegs { u32x4 kv[4], vv[4]; bf16x8 qf[2]; };
struct UnitIdx { int p, b, h, dl, r, nb; };
__device__ __forceinline__ UnitIdx decode(int u, int half) {
    UnitIdx x; x.p = u >> 10; const int rem = u & 1023, bh = rem >> 5, xx = rem & 31; x.b = 4 * half + (bh >> 3); x.h = bh & 7;
    x.dl = (x.p == 0) ? 1 : (x.p == 1) ? 4 : 16; const int lgn = (x.p == 0) ? 5 : (x.p == 1) ? 3 : 1;
    x.r = xx >> lgn; x.nb = xx & ((1 << lgn) - 1); return x;
}
__device__ __forceinline__ void load_unit(UnitRegs& R, const bf16* Q, const bf16* K, const bf16* V, int u, int half) {
    const int tid = TIDX(), lane = tid & 63, wid = __builtin_amdgcn_readfirstlane(tid >> 6), ql = lane & 15, g = lane >> 4;
    const UnitIdx x = decode(u, half); const size_t rowb = (size_t)x.b * SEQ;
#pragma unroll
    for (int i = 0; i < 4; ++i) {
        const int q = tid + 512 * i, j = q >> 3, c8 = q & 7, mi = 128 * (x.nb - 1) + j;
        R.kv[i] = (u32x4){0u, 0u, 0u, 0u}; R.vv[i] = R.kv[i];
        if (mi >= 0) { const size_t src = (rowb + (size_t)(mi * x.dl + x.r)) * 512 + x.h * 64 + c8 * 8; R.kv[i] = *(const u32x4*)(K + src); R.vv[i] = *(const u32x4*)(V + src); }
    }
    const int iq = 16 * wid + ql; const size_t qrow = rowb + (size_t)((128 * x.nb + iq) * x.dl + x.r);
#pragma unroll
    for (int ks = 0; ks < 2; ++ks) R.qf[ks] = *(const bf16x8*)(Q + qrow * 512 + x.h * 64 + 32 * ks + 8 * g);
}
__device__ __forceinline__ void attn_units(LAS unsigned char* lds, const bf16* Q, const bf16* K, const bf16* V, bf16* OP, float* LSE, int u0, int n, int half) {
    const int tid = TIDX(), lane = tid & 63, wid = __builtin_amdgcn_readfirstlane(tid >> 6), ql = lane & 15, g = lane >> 4;
    if (n <= 0) return;
#define ATT_UNIT(L_) ((((L_) % 12) >> 2) * 1024 + ((L_) / 12) * 4 + ((L_) & 3))
    UnitRegs R; load_unit(R, Q, K, V, ATT_UNIT(u0), half);
    for (int ui = 0; ui < n; ++ui) {
        const int u = ATT_UNIT(u0 + ui); const UnitIdx x = decode(u, half); const int nb = x.nb, p = x.p, h = x.h;
#pragma unroll
        for (int i = 0; i < 4; ++i) { const int q = tid + 512 * i, j = q >> 3, c8 = q & 7;
            *(LAS u32x4*)(lds + LDS_K + j * KSTR + c8 * 16) = R.kv[i]; *(LAS u32x4*)(lds + LDS_V + j * KSTR + c8 * 16) = R.vv[i]; }
        const bf16x8 qf0 = R.qf[0], qf1 = R.qf[1];
        WG_BAR();
        if (ui + 1 < n) load_unit(R, Q, K, V, ATT_UNIT(u0 + ui + 1), half);
        const int iq = 16 * wid + ql; const size_t qrow = (size_t)x.b * SEQ + (size_t)((128 * nb + iq) * x.dl + x.r);
        float sc[9][4]; float mx = -INFINITY;
        f32x4 acc9[9];
        {
#define ATT_KF(t_, h_) (*(const LAS bf16x8*)(lds + LDS_K + (16 * (wid + (t_)) + ql) * KSTR + 64 * (h_) + 16 * g))
#define ATT_LD2(KX, t_) do { KX[0][0] = ATT_KF(t_, 0); KX[0][1] = ATT_KF(t_, 1); KX[1][0] = ATT_KF((t_) + 1, 0); KX[1][1] = ATT_KF((t_) + 1, 1); } while (0)
#define ATT_MM2(KX, t_) do { const f32x4 z_ = (f32x4){0.f, 0.f, 0.f, 0.f}; acc9[t_] = mfma16(KX[0][0], qf0, z_); acc9[(t_) + 1] = mfma16(KX[1][0], qf0, z_); \
            acc9[t_] = mfma16(KX[0][1], qf1, acc9[t_]); acc9[(t_) + 1] = mfma16(KX[1][1], qf1, acc9[(t_) + 1]); } while (0)
            bf16x8 kx[2][2], ky[2][2];
            ATT_LD2(kx, 0);
            __builtin_amdgcn_sched_group_barrier(0x100, 4, 0);
            ATT_LD2(ky, 2); ATT_MM2(kx, 0);
            __builtin_amdgcn_sched_group_barrier(0x100, 4, 0); __builtin_amdgcn_sched_group_barrier(0x8, 4, 0);
            ATT_LD2(kx, 4); ATT_MM2(ky, 2);
            __builtin_amdgcn_sched_group_barrier(0x100, 4, 0); __builtin_amdgcn_sched_group_barrier(0x8, 4, 0);
            ATT_LD2(ky, 6); ATT_MM2(kx, 4);
            __builtin_amdgcn_sched_group_barrier(0x100, 4, 0); __builtin_amdgcn_sched_group_barrier(0x8, 4, 0);
            kx[0][0] = ATT_KF(8, 0); kx[0][1] = ATT_KF(8, 1); ATT_MM2(ky, 6);
            __builtin_amdgcn_sched_group_barrier(0x100, 2, 0); __builtin_amdgcn_sched_group_barrier(0x8, 4, 0);
            { const f32x4 z_ = (f32x4){0.f, 0.f, 0.f, 0.f}; acc9[8] = mfma16(kx[0][0], qf0, z_); acc9[8] = mfma16(kx[0][1], qf1, acc9[8]); }
            __builtin_amdgcn_sched_group_barrier(0x8, 2, 0);
#undef ATT_KF
#undef ATT_LD2
#undef ATT_MM2
        }
#pragma unroll
        for (int tt = 0; tt < 9; ++tt) {
            const bool live = nb > 0 || wid + tt >= 8;
#pragma unroll
            for (int rg = 0; rg < 4; ++rg) {
                float v = acc9[tt][rg];
                if (tt == 0) v = (4 * g + rg >= ql) ? v : -INFINITY;
                if (tt == 8) v = (4 * g + rg <= ql) ? v : -INFINITY;
                v = live ? v : -INFINITY;
                sc[tt][rg] = v; mx = fmaxf(mx, v); }
        }
        mx = fmaxf(mx, __shfl_xor(mx, 16)); mx = fmaxf(mx, __shfl_xor(mx, 32));
        float l = 0.f;
#pragma unroll
        for (int tt = 0; tt < 9; ++tt)
#pragma unroll
            for (int rg = 0; rg < 4; ++rg) { sc[tt][rg] = __builtin_amdgcn_exp2f(sc[tt][rg] - mx); l += sc[tt][rg]; }
        l += __shfl_xor(l, 16); l += __shfl_xor(l, 32);
        f32x4 o[4];
#pragma unroll
        for (int dt = 0; dt < 4; ++dt) o[dt] = (f32x4){0.f, 0.f, 0.f, 0.f};
        {
#define ATT_LDV(VX, pp_) do { const int t0_ = wid + 2 * (pp_); int t1_ = t0_ + 1; if (t1_ > 15) t1_ = 15;              \
            const LAS unsigned char* v0_ = lds + LDS_V + (16 * t0_ + 4 * g + (ql >> 2)) * KSTR + 8 * (ql & 3); \
            const LAS unsigned char* v1_ = lds + LDS_V + (16 * t1_ + 4 * g + (ql >> 2)) * KSTR + 8 * (ql & 3); \
            _Pragma("unroll") for (int dt = 0; dt < 4; ++dt) VX[dt] = cat8(vtr(v0_ + 32 * dt), vtr(v1_ + 32 * dt)); } while (0)
#define ATT_MMV(VX, pp_) do { u32x4 pw_; pw_.x = cvt_pk_bf16(sc[2 * (pp_)][0], sc[2 * (pp_)][1]); pw_.y = cvt_pk_bf16(sc[2 * (pp_)][2], sc[2 * (pp_)][3]); \
            if ((pp_) < 4) { pw_.z = cvt_pk_bf16(sc[(2 * (pp_) + 1) % 9][0], sc[(2 * (pp_) + 1) % 9][1]); pw_.w = cvt_pk_bf16(sc[(2 * (pp_) + 1) % 9][2], sc[(2 * (pp_) + 1) % 9][3]); } else { pw_.z = 0u; pw_.w = 0u; } \
            const bf16x8 pf_ = __builtin_bit_cast(bf16x8, pw_); \
            _Pragma("unroll") for (int dt = 0; dt < 4; ++dt) o[dt] = mfma16(VX[dt], pf_, o[dt]); } while (0)
            bf16x8 vfa[4], vfb[4];
            ATT_LDV(vfa, 0);
            __builtin_amdgcn_sched_group_barrier(0x100, 8, 0);
            ATT_LDV(vfb, 1); ATT_MMV(vfa, 0);
            __builtin_amdgcn_sched_group_barrier(0x100, 8, 0); __builtin_amdgcn_sched_group_barrier(0x8, 4, 0);
            ATT_LDV(vfa, 2); ATT_MMV(vfb, 1);
            __builtin_amdgcn_sched_group_barrier(0x100, 8, 0); __builtin_amdgcn_sched_group_barrier(0x8, 4, 0);
            ATT_LDV(vfb, 3); ATT_MMV(vfa, 2);
            __builtin_amdgcn_sched_group_barrier(0x100, 8, 0); __builtin_amdgcn_sched_group_barrier(0x8, 4, 0);
            ATT_LDV(vfa, 4); ATT_MMV(vfb, 3);
            __builtin_amdgcn_sched_group_barrier(0x100, 8, 0); __builtin_amdgcn_sched_group_barrier(0x8, 4, 0);
            ATT_MMV(vfa, 4);
            __builtin_amdgcn_sched_group_barrier(0x8, 4, 0);
#undef ATT_LDV
#undef ATT_MMV
        }
        const float il = __builtin_amdgcn_rcpf(l);
        bf16* orow = OP + ((size_t)p * pg8::MH + qrow) * 512 + h * 64 + 4 * g;
#pragma unroll
        for (int dt = 0; dt < 4; ++dt) { u32x2 w; w.x = cvt_pk_bf16(o[dt][0] * il, o[dt][1] * il); w.y = cvt_pk_bf16(o[dt][2] * il, o[dt][3] * il); *(u32x2*)(orow + 16 * dt) = w; }
        if (g == 0) LSE[((size_t)p * M_TOK + qrow) * 8 + h] = mx + __builtin_amdgcn_logf(l);
        WG_BAR();
    }
#undef ATT_UNIT
}
}

__device__ __forceinline__ void merge_sconv_phase(int gtid, int nthreads, const bf16* __restrict__ OP, const float* __restrict__ LSE, const bf16* __restrict__ GB, const bf16* __restrict__ PR, const float* __restrict__ scw, bf16* __restrict__ AB, int half) {
    const int grp = gtid & 127, N = pg8::MH * 128;
    if (grp < 64) {
        const int h = grp >> 3;
        for (int it = gtid; it < N; it += 2 * nthreads) {
            const bool two = it + nthreads < N;
            const int row0 = half * pg8::MH + (it >> 7), row1 = two ? half * pg8::MH + ((it + nthreads) >> 7) : row0;
            float l[2][3]; u32x4 x[2][3];
#pragma unroll
            for (int i = 0; i < 2; ++i) { const int row = i ? row1 : row0;
#pragma unroll
                for (int p = 0; p < 3; ++p) { l[i][p] = LSE[((size_t)p * M_TOK + row) * 8 + h]; x[i][p] = *(const u32x4*)(OP + ((size_t)p * pg8::MH + row) * 512 + grp * 8); } }
#pragma unroll
            for (int i = 0; i < 2; ++i) { const int row = i ? row1 : row0;
                const float mx = fmaxf(l[i][0], fmaxf(l[i][1], l[i][2]));
                float w0 = __builtin_amdgcn_exp2f(l[i][0] - mx), w1 = __builtin_amdgcn_exp2f(l[i][1] - mx), w2 = __builtin_amdgcn_exp2f(l[i][2] - mx);
                const float inv = __builtin_amdgcn_rcpf(w0 + w1 + w2); w0 *= inv; w1 *= inv; w2 *= inv;
                float r[8];
#pragma unroll
                for (int j = 0; j < 4; ++j) { r[2 * j] = w0 * bflo(x[i][0][j]) + w1 * bflo(x[i][1][j]) + w2 * bflo(x[i][2][j]); r[2 * j + 1] = w0 * bfhi(x[i][0][j]) + w1 * bfhi(x[i][1][j]) + w2 * bfhi(x[i][2][j]); }
                u32x4 w; w.x = cvt_pk_bf16(r[0], r[1]); w.y = cvt_pk_bf16(r[2], r[3]); w.z = cvt_pk_bf16(r[4], r[5]); w.w = cvt_pk_bf16(r[6], r[7]);
                if (i == 0 || two) *(u32x4*)(AB + (size_t)row * 1024 + grp * 8) = w; }
        }
    } else {
        const int c0 = (grp - 64) * 8;
        f32x4 wa[3], wb[3];
#pragma unroll
        for (int k = 0; k < 3; ++k) { wa[k] = *(const f32x4*)(scw + k * 512 + c0); wb[k] = *(const f32x4*)(scw + k * 512 + c0 + 4); }
        for (int it = gtid; it < N; it += 2 * nthreads) {
            const bool two = it + nthreads < N;
            const int row0 = half * pg8::MH + (it >> 7), row1 = two ? half * pg8::MH + ((it + nthreads) >> 7) : row0;
            u32x4 gb[2], pr[2][3];
#pragma unroll
            for (int i = 0; i < 2; ++i) { const int row = i ? row1 : row0, t = row & (SEQ - 1);
                gb[i] = *(const u32x4*)(GB + (size_t)row * 512 + c0);
#pragma unroll
                for (int k = 0; k < 3; ++k) pr[i][k] = (t >= 2 - k) ? *(const u32x4*)(PR + (size_t)(row - (2 - k)) * 512 + c0) : (u32x4){0u, 0u, 0u, 0u}; }
#pragma unroll
            for (int i = 0; i < 2; ++i) { const int row = i ? row1 : row0;
                float acc[8];
#pragma unroll
                for (int j = 0; j < 8; ++j) acc[j] = 0.f;
#pragma unroll
                for (int k = 0; k < 3; ++k)
#pragma unroll
                    for (int j = 0; j < 4; ++j) { const float wl = (j < 2) ? wa[k][2 * j] : wb[k][2 * j - 4], wh = (j < 2) ? wa[k][2 * j + 1] : wb[k][2 * j - 3];
                        acc[2 * j] += wl * bflo(pr[i][k][j]); acc[2 * j + 1] += wh * bfhi(pr[i][k][j]); }
                u32x4 w; w.x = cvt_pk_bf16(bflo(gb[i].x) * acc[0], bfhi(gb[i].x) * acc[1]); w.y = cvt_pk_bf16(bflo(gb[i].y) * acc[2], bfhi(gb[i].y) * acc[3]);
                w.z = cvt_pk_bf16(bflo(gb[i].z) * acc[4], bfhi(gb[i].z) * acc[5]); w.w = cvt_pk_bf16(bflo(gb[i].w) * acc[6], bfhi(gb[i].w) * acc[7]);
                if (i == 0 || two) *(u32x4*)(AB + (size_t)row * 1024 + grp * 8) = w; }
        }
    }
}

namespace ret {
constexpr int KRS = 528, VRS = 144;
constexpr int SA_LDS_BYTES = 2 * 128 * KRS;
__device__ __forceinline__ void score_tiles(LAS unsigned char* kl, const bf16x8 (&qf)[8], bf16* P, int ch, int qt, int ql, int g) {
    const int iq = 16 * qt + ql;
    bf16* prow = P + ((size_t)ch * 128 + iq) * 128 + 4 * g;
#pragma unroll 1
    for (int kt = 0; kt <= qt; ++kt) {
        f32x4 a = (f32x4){0.f, 0.f, 0.f, 0.f};
#pragma unroll
        for (int ks = 0; ks < 8; ++ks) { const bf16x8 kf = *(const LAS bf16x8*)(kl + (16 * kt + ql) * KRS + 64 * ks + 16 * g); a = mfma16(kf, qf[ks], a); }
        float pr[4];
#pragma unroll
        for (int rg = 0; rg < 4; ++rg) pr[rg] = (16 * kt + 4 * g + rg <= iq) ? a[rg] : 0.f;
        u32x2 w; w.x = cvt_pk_bf16(pr[0], pr[1]); w.y = cvt_pk_bf16(pr[2], pr[3]); *(u32x2*)(prow + 16 * kt) = w;
    }
    if ((qt & 1) == 0) *(u32x2*)(prow + 16 * (qt + 1)) = (u32x2){0u, 0u};
}
__device__ __forceinline__ void score_pair(LAS unsigned char* lds, const bf16* Q, const bf16* K, bf16* P, int pr) {
    const int tid = TIDX(), lane = tid & 63, wid = __builtin_amdgcn_readfirstlane(tid >> 6), ql = lane & 15, g = lane >> 4;
    bf16x8 qfa[8], qfb[8];
#pragma unroll
    for (int s = 0; s < 2; ++s) {
        const int ch = 2 * pr + s, b = ch >> 7, h = (ch >> 5) & 3, c = ch & 31; const size_t t0 = (size_t)b * SEQ + 128 * c;
        u32x4 kr[8];
#pragma unroll
        for (int i = 0; i < 8; ++i) { const int q = tid + 512 * i, key = q >> 5, c16 = q & 31; kr[i] = *(const u32x4*)(K + (t0 + key) * 1024 + h * 256 + c16 * 8); }
        const int iq = 16 * (s ? 7 - wid : wid) + ql;
#pragma unroll
        for (int ks = 0; ks < 8; ++ks) { const bf16x8 v = *(const bf16x8*)(Q + (t0 + iq) * 1024 + h * 256 + 32 * ks + 8 * g); if (s) qfb[ks] = v; else qfa[ks] = v; }
#pragma unroll
        for (int i = 0; i < 8; ++i) { const int q = tid + 512 * i, key = q >> 5, c16 = q & 31; *(LAS u32x4*)(lds + s * 128 * KRS + key * KRS + c16 * 16) = kr[i]; }
    }
    WG_BAR();
    score_tiles(lds, qfa, P, 2 * pr, wid, ql, g);
    score_tiles(lds + 128 * KRS, qfb, P, 2 * pr + 1, 7 - wid, ql, g);
    WG_BAR();
}

constexpr int SRS = 544;
constexpr int LDS_KC = 0, LDS_VK = 128 * KRS, LDS_SB = LDS_VK + 128 * VRS, LDS_BYTES = LDS_SB + 64 * SRS;
struct ChunkRegs { u32x4 k[8], v[2]; bf16x8 p[4]; };
__device__ __forceinline__ void load_chunk(ChunkRegs& R, const bf16* K, const bf16* V, const bf16* P, size_t t0, int ch, int h, int sl, int qt) {
    const int tid = TIDX(), lane = tid & 63, wid = __builtin_amdgcn_readfirstlane(tid >> 6), ql = lane & 15, g = lane >> 4;
#pragma unroll
    for (int i = 0; i < 8; ++i) { const int q = tid + 512 * i, key = q >> 5, c16 = q & 31; R.k[i] = *(const u32x4*)(K + (t0 + key) * 1024 + h * 256 + c16 * 8); }
#pragma unroll
    for (int i = 0; i < 2; ++i) { const int q = tid + 512 * i, key = q >> 3, c8 = q & 7; R.v[i] = *(const u32x4*)(V + (t0 + key) * 2048 + h * 512 + sl * 64 + c8 * 8); }
    const bf16* prow = P + ((size_t)ch * 128 + 16 * qt + ql) * 128 + 8 * g;
#pragma unroll
    for (int kp = 0; kp < 4; ++kp) R.p[kp] = (2 * kp <= qt) ? *(const bf16x8*)(prow + 32 * kp) : (bf16x8){0, 0, 0, 0, 0, 0, 0, 0};
}
__device__ __forceinline__ void load_q(bf16x8 (&qf)[8], const bf16* Q, size_t t0, int h, int qt) {
    const int tid = TIDX(), lane = tid & 63, wid = __builtin_amdgcn_readfirstlane(tid >> 6), ql = lane & 15, g = lane >> 4;
    const int iq = 16 * qt + ql;
#pragma unroll
    for (int ks = 0; ks < 8; ++ks) qf[ks] = *(const bf16x8*)(Q + (t0 + iq) * 1024 + h * 256 + 32 * ks + 8 * g);
}
__device__ __forceinline__ void ret_item(LAS unsigned char* lds, const bf16* Q, const bf16* K, bf16* V, const bf16* P, float* GNS, int item) {
    const int tid = TIDX(), lane = tid & 63, wid = __builtin_amdgcn_readfirstlane(tid >> 6), ql = lane & 15, g = lane >> 4;
    const int b = item >> 5, h = (item >> 3) & 3, sl = item & 7, ch0 = (b * 4 + h) * 32;
    const float lg = __builtin_amdgcn_logf(1.0f - __builtin_amdgcn_exp2f((float)(-5 - h)));
    const float cdec = __builtin_amdgcn_exp2f(lg * 128.0f);
    const int qt = wid < 4 ? wid : 11 - wid;
    ChunkRegs R; load_chunk(R, K, V, P, (size_t)b * SEQ, ch0, h, sl, qt);
    bf16x8 qf[8]; load_q(qf, Q, (size_t)b * SEQ, h, qt);
    f32x4 st[2][4];
#pragma unroll
    for (int dd = 0; dd < 2; ++dd)
#pragma unroll
        for (int et = 0; et < 4; ++et) st[dd][et] = (f32x4){0.f, 0.f, 0.f, 0.f};
    const int iq = 16 * qt + ql;
    const float qdec = __builtin_amdgcn_exp2f(lg * (float)(iq + 1)), pdec = __builtin_amdgcn_exp2f(lg * (float)(iq - 127));
    for (int c = 0; c < 32; ++c) {
        const size_t t0 = (size_t)b * SEQ + 128 * c;
#pragma unroll
        for (int i = 0; i < 8; ++i) { const int q = tid + 512 * i, key = q >> 5, c16 = q & 31; *(LAS u32x4*)(lds + LDS_KC + key * KRS + c16 * 16) = R.k[i]; }
#pragma unroll
        for (int i = 0; i < 2; ++i) { const int q = tid + 512 * i, key = q >> 3, c8 = q & 7;
            const u32x4 v = R.v[i];
            const float kd = __builtin_amdgcn_exp2f(lg * (float)(127 - key));
            u32x4 vk;
            vk.x = cvt_pk_bf16(bflo(v.x) * kd, bfhi(v.x) * kd); vk.y = cvt_pk_bf16(bflo(v.y) * kd, bfhi(v.y) * kd); vk.z = cvt_pk_bf16(bflo(v.z) * kd, bfhi(v.z) * kd); vk.w = cvt_pk_bf16(bflo(v.w) * kd, bfhi(v.w) * kd);
            *(LAS u32x4*)(lds + LDS_VK + key * VRS + c8 * 16) = vk; }
#pragma unroll
        for (int dd = 0; dd < 2; ++dd)
#pragma unroll
            for (int et = 0; et < 4; ++et) { u32x2 w; w.x = cvt_pk_bf16(st[dd][et][0], st[dd][et][1]); w.y = cvt_pk_bf16(st[dd][et][2], st[dd][et][3]);
                *(LAS u32x2*)(lds + LDS_SB + (16 * et + ql) * SRS + (32 * wid + 16 * dd + 4 * g) * 2) = w; }
        bf16x8 pf[4];
#pragma unroll
        for (int kp = 0; kp < 4; ++kp) pf[kp] = R.p[kp];
        WG_BAR();
        if (c + 1 < 32) load_chunk(R, K, V, P, t0 + 128, ch0 + c + 1, h, sl, qt);
        f32x4 o[4], qs[4];
#pragma unroll
        for (int et = 0; et < 4; ++et) { o[et] = (f32x4){0.f, 0.f, 0.f, 0.f}; qs[et] = o[et]; }
#pragma unroll
        for (int kp = 0; kp < 4; ++kp) {
            if (2 * kp <= qt) {
                const LAS unsigned char* v0 = lds + LDS_VK + (32 * kp + 8 * g + (ql >> 2)) * VRS + 8 * (ql & 3);
#pragma unroll
                for (int et = 0; et < 4; ++et) { const bf16x8 vf = cat8(vtr(v0 + 32 * et), vtr(v0 + 4 * VRS + 32 * et)); o[et] = mfma16(vf, pf[kp], o[et]); }
            }
        }
#pragma unroll
        for (int dd = 0; dd < 2; ++dd)
#pragma unroll
            for (int et = 0; et < 4; ++et) st[dd][et] = st[dd][et] * cdec;
#pragma unroll 1
        for (int kk = 0; kk < 4; ++kk) {
            bf16x8 kfr[2], vfr[4];
            const LAS unsigned char* k0 = lds + LDS_KC + (32 * kk + 8 * g + (ql >> 2)) * KRS + 64 * wid + 8 * (ql & 3);
            const LAS unsigned char* v0 = lds + LDS_VK + (32 * kk + 8 * g + (ql >> 2)) * VRS + 8 * (ql & 3);
#pragma unroll
            for (int dd = 0; dd < 2; ++dd) kfr[dd] = cat8(vtr(k0 + 32 * dd), vtr(k0 + 4 * KRS + 32 * dd));
#pragma unroll
            for (int et = 0; et < 4; ++et) vfr[et] = cat8(vtr(v0 + 32 * et), vtr(v0 + 4 * VRS + 32 * et));
#pragma unroll
            for (int dd = 0; dd < 2; ++dd)
#pragma unroll
                for (int et = 0; et < 4; ++et) st[dd][et] = mfma16(kfr[dd], vfr[et], st[dd][et]);
        }
        {
            const LAS unsigned char* sb0 = lds + LDS_SB + ql * SRS + 16 * g;
            bf16x8 sfa[4], sfb[4];
#pragma unroll
            for (int et = 0; et < 4; ++et) sfa[et] = *(const LAS bf16x8*)(sb0 + 16 * et * SRS);
            __builtin_amdgcn_sched_group_barrier(0x100, 4, 0);
#pragma unroll
            for (int ks = 0; ks < 8; ks += 2) {
#pragma unroll
                for (int et = 0; et < 4; ++et) sfb[et] = *(const LAS bf16x8*)(sb0 + 16 * et * SRS + 64 * (ks + 1));
#pragma unroll
                for (int et = 0; et < 4; ++et) qs[et] = mfma16(sfa[et], qf[ks], qs[et]);
                __builtin_amdgcn_sched_group_barrier(0x100, 4, 0); __builtin_amdgcn_sched_group_barrier(0x8, 4, 0);
                if (ks + 2 < 8) {
#pragma unroll
                    for (int et = 0; et < 4; ++et) sfa[et] = *(const LAS bf16x8*)(sb0 + 16 * et * SRS + 64 * (ks + 2));
                }
#pragma unroll
                for (int et = 0; et < 4; ++et) qs[et] = mfma16(sfb[et], qf[ks + 1], qs[et]);
                if (ks + 2 < 8) __builtin_amdgcn_sched_group_barrier(0x100, 4, 0);
                __builtin_amdgcn_sched_group_barrier(0x8, 4, 0);
            }
        }
        float s1 = 0.f, s2 = 0.f;
        bf16* orow = V + (t0 + iq) * 2048 + h * 512 + sl * 64 + 4 * g;
#pragma unroll
        for (int et = 0; et < 4; ++et) {
            const f32x4 r = o[et] * pdec + qs[et] * qdec;
            s1 += (r[0] + r[1]) + (r[2] + r[3]); s2 += (r[0] * r[0] + r[1] * r[1]) + (r[2] * r[2] + r[3] * r[3]);
            u32x2 w; w.x = cvt_pk_bf16(r[0], r[1]); w.y = cvt_pk_bf16(r[2], r[3]); *(u32x2*)(orow + 16 * et) = w;
        }
        s1 = pg8::xor16_32_sum(s1); s2 = pg8::xor16_32_sum(s2);
        if (g == 0) { float* gp = GNS + (((size_t)(t0 + iq)) * 4 + h) * 16 + sl * 2; gp[0] = s1; gp[1] = s2; }
        WG_BAR();
        if (c + 1 < 32) load_q(qf, Q, t0 + 128, h, qt);
    }
}
}

constexpr size_t MiB = 1u << 20;
constexpr size_t WS_CTL = 0, CTL_ZERO_BYTES = 1 * MiB;
constexpr size_t WS_SSQ = 1 * MiB;
constexpr size_t WS_GNS = 3 * MiB;
constexpr size_t WS_COS = 11 * MiB, WS_SIN = 13 * MiB;
constexpr size_t WS_UF = 15 * MiB, WS_UL = 21 * MiB;
constexpr size_t WS_LSE = 27 * MiB;
constexpr size_t WS_MR = 30 * MiB;
constexpr size_t WS_WIN = 32 * MiB, WS_WOUT = 38 * MiB, WS_WQKV = 40 * MiB, WS_WG = 48 * MiB, WS_WO = 52 * MiB, WS_UP0 = 56 * MiB, WS_UP1 = 67 * MiB;
constexpr size_t WS_DN0 = 78 * MiB, WS_DN1 = WS_DN0 + (size_t)DM * DFF * 2;
constexpr size_t WS_XB = 90 * MiB;
constexpr size_t WS_R = 154 * MiB, HALF_REGION = 176 * MiB;
constexpr size_t RO_PROJ = 0;
constexpr size_t RO_OP = 80 * MiB;
constexpr size_t RO_AB = 128 * MiB;
constexpr size_t RO_HID = 0;
constexpr size_t RO_Q1 = 0, RO_K1 = 32 * MiB, RO_V1 = 64 * MiB;
constexpr size_t RO_PS = 128 * MiB;
constexpr size_t WS_END = WS_R + 2 * HALF_REGION;
static_assert(WS_DN1 + (size_t)DM * DFF * 2 <= WS_XB && WS_END <= 512 * MiB && RO_AB + 32 * MiB <= HALF_REGION && RO_PS + 16 * MiB <= HALF_REGION, "d_ws map");

constexpr int RING_OFF = 0, RING_BYTES = 131072;
constexpr int XCH_OFF = RING_BYTES, XCH_BYTES = 24576;
constexpr int MISC_OFF = XCH_OFF + XCH_BYTES;
constexpr int LDS_BYTES = 163840;
static_assert(att::LDS_BYTES <= MISC_OFF && ret::LDS_BYTES <= MISC_OFF && ret::SA_LDS_BYTES <= MISC_OFF && MISC_OFF + 256 <= LDS_BYTES, "LDS map");
constexpr int NWAVES = 8;

constexpr int N_EVENTS = 28;
#define EV_TMO       128
#define EV_XCNT(j)   (256 + 64 * (j))
#define EV_XSUB(e,j) (2048 + 64 * (16 * (e) + (j)))
#define EV_TOP(e)    (32768 + 64 * (e))
#define EV_DONE(e)   (36864 + 64 * (e))
static_assert((36864 + 64 * N_EVENTS) * 4 <= (int)CTL_ZERO_BYTES && 2048 + 64 * 16 * N_EVENTS <= 32768, "event words inside the memset region");
#define EV_SPIN_CAP (1u << 22)
__device__ __forceinline__ unsigned ev_ld(unsigned* p)              { return __hip_atomic_load(p, __ATOMIC_RELAXED, __HIP_MEMORY_SCOPE_AGENT); }
__device__ __forceinline__ unsigned ev_add(unsigned* p, unsigned v) { return __hip_atomic_fetch_add(p, v, __ATOMIC_RELAXED, __HIP_MEMORY_SCOPE_AGENT); }
__device__ __forceinline__ unsigned ev_xcc_id() { return (unsigned)__builtin_amdgcn_s_getreg((3 << 11) | 20) & 0xFu; }
#define EV_SPIN(cond, ctl) do { unsigned _sp = 0; while (cond) { __builtin_amdgcn_s_sleep(1); \
    if ((++_sp & 255u) == 0u) { if (ev_ld(&(ctl)[EV_TMO])) break; if (_sp > EV_SPIN_CAP) { atomicAdd(&(ctl)[EV_TMO], 1u); break; } } } } while (0)
struct Events { unsigned* ctl; unsigned x; volatile LAS unsigned* st; };
__device__ __forceinline__ Events events_post(unsigned* ctl, volatile LAS unsigned* st) {
    Events b; b.ctl = ctl; b.x = ev_xcc_id(); b.st = st;
    if (threadIdx.x == 0) (void)ev_add(&ctl[EV_XCNT(b.x)], 1u);
    return b;
}
__device__ __forceinline__ void events_census(unsigned* ctl, unsigned x, unsigned& nloc, unsigned& nx) {
    const unsigned G = gridDim.x * gridDim.y * gridDim.z;
    unsigned sum, cnt, mine, sp = 0u;
    for (;;) {
        sum = 0u; cnt = 0u; mine = 0u;
#pragma unroll
        for (unsigned j = 0; j < 16; ++j) { const unsigned c = ev_ld(&ctl[EV_XCNT(j)]); sum += c; cnt += (c > 0u) ? 1u : 0u; mine = (j == x) ? c : mine; }
        if (sum == G) break;
        __builtin_amdgcn_s_sleep(1);
        if ((++sp & 255u) == 0u) { if (ev_ld(&ctl[EV_TMO])) break; if (sp > EV_SPIN_CAP) { atomicAdd(&ctl[EV_TMO], 1u); break; } }
    }
    nloc = mine > 0u ? mine : 1u; nx = cnt > 0u ? cnt : 1u;
}
__device__ __forceinline__ void ev_step(const Events& b, int ea, int ew) {
    unsigned* ctl = b.ctl;
    const int tid = TIDX();
    unsigned d = 1u, old = 0u;
    if (ew >= 0 && tid == 64) d = (b.st[5] == (unsigned)(ew + 1)) ? 2u : ev_ld(&ctl[EV_DONE(ew)]);
    asm volatile("s_waitcnt vmcnt(0)" ::: "memory");
    WG_BAR();
    if (ea >= 0 && tid == 128) old = ev_add(&ctl[EV_XSUB(ea, b.x)], 1u);
    if (ew >= 0 && tid == 64 && d != 2u) {
        if (d == 0u) EV_SPIN(ev_ld(&ctl[EV_DONE(ew)]) == 0u, ctl);
        __builtin_amdgcn_fence(__ATOMIC_ACQUIRE, "agent");
        asm volatile("s_waitcnt vmcnt(0)" ::: "memory");
    }
    WG_BAR();
    if (ea >= 0 && tid == 128) {
        unsigned nloc = b.st[0], nx = b.st[1];
        if (nloc == 0u) { events_census(ctl, b.x, nloc, nx); b.st[0] = nloc; b.st[1] = nx; }
        if (old + 1u == nloc) {
            __builtin_amdgcn_fence(__ATOMIC_RELEASE, "agent");
            asm volatile("s_waitcnt vmcnt(0)" ::: "memory");
            const unsigned og = ev_add(&ctl[EV_TOP(ea)], 1u);
            if (og + 1u == nx) __hip_atomic_store(&ctl[EV_DONE(ea)], 1u, __ATOMIC_RELAXED, __HIP_MEMORY_SCOPE_AGENT);
        }
    }
}

__device__ __forceinline__ void ev_wait_wave(unsigned* ctl, volatile LAS unsigned* flag, int e) {
    const int wid = __builtin_amdgcn_readfirstlane(TIDX() >> 6);
    if (wid == 0) {
        EV_SPIN(ev_ld(&ctl[EV_DONE(e)]) == 0u, ctl);
        __builtin_amdgcn_fence(__ATOMIC_ACQUIRE, "agent");
        asm volatile("s_waitcnt vmcnt(0)" ::: "memory");
        *flag = (unsigned)(e + 1);
        asm volatile("s_waitcnt lgkmcnt(0)" ::: "memory");
    } else {
        EV_SPIN(*flag != (unsigned)(e + 1), ctl);
    }
}
__device__ __forceinline__ void ev_arrive_inl(const Events& b, int e) {
    asm volatile("s_waitcnt vmcnt(0)" ::: "memory");
    WG_BAR();
    if (TIDX() == 128) {
        unsigned* ctl = b.ctl;
        const unsigned nloc = b.st[0], nx = b.st[1];
        const unsigned old = ev_add(&ctl[EV_XSUB(e, b.x)], 1u);
        if (old + 1u == nloc) {
            __builtin_amdgcn_fence(__ATOMIC_RELEASE, "agent");
            asm volatile("s_waitcnt vmcnt(0)" ::: "memory");
            const unsigned og = ev_add(&ctl[EV_TOP(e)], 1u);
            if (og + 1u == nx) __hip_atomic_store(&ctl[EV_DONE(e)], 1u, __ATOMIC_RELAXED, __HIP_MEMORY_SCOPE_AGENT);
        }
    }
}
struct PairOrder {
    int nN, nwg, G, c0, c1, nA; size_t a_hd; unsigned* ctl; unsigned x; volatile LAS unsigned* st; int ea, ew;
    __device__ __forceinline__ void init(int N, int G_, int c, size_t a_half_delta, const Events& e, int e_arrive, int e_wait) {
        nN = N / pg8::BM; nwg = (pg8::MH / pg8::BM) * nN; G = G_; c0 = c; c1 = G_ - 1 - c; nA = c < nwg ? (nwg - c + G_ - 1) / G_ : 0;
        a_hd = a_half_delta; ctl = e.ctl; x = e.x; st = e.st; ea = e_arrive; ew = e_wait; }
    __device__ __forceinline__ bool next(int i, pg8::Unit& u) const {
        const bool h = i >= nA; const long L = (long)(h ? i - nA : i) * G + (h ? c1 : c0); if (L >= nwg) return false;
        int wgid = (int)L; { const int q = nwg / pg8::NXCD, r = nwg % pg8::NXCD, xcd = wgid % pg8::NXCD, off = wgid / pg8::NXCD; wgid = (xcd < r ? xcd * (q + 1) : r * (q + 1) + (xcd - r) * q) + off; }
        constexpr int nM = pg8::MH / pg8::BM; static_assert(nM % pg8::WGM == 0, "whole row-tile groups"); const int nig = pg8::WGM * nN, gid = wgid / nig, fm = gid * pg8::WGM; constexpr int gsz = pg8::WGM;
        u.pm = fm + ((wgid % nig) % gsz) + (h ? nM : 0); u.pn = (wgid % nig) / gsz; return true; }
    __device__ __forceinline__ void a_ready(const pg8::Unit&, int i) const { if (i == nA && ew >= 0) ev_wait_wave(ctl, st + 4, ew); }
    __device__ __forceinline__ void done(const pg8::Unit&, int i) const { if (i == nA - 1) { Events b; b.ctl = ctl; b.x = x; b.st = st; ev_arrive_inl(b, ea); } }
    __device__ __forceinline__ size_t a_off(const pg8::Unit& u) const { return u.pm >= pg8::MH / pg8::BM ? a_hd : (size_t)0; }
    __device__ __forceinline__ void early() const { pg8::ev_early_acquire(&ctl[EV_DONE(ea)], st + 5, (unsigned)(ea + 1)); }
};

__device__ __forceinline__ int map_col(int mode, int pcol0) {
    if (mode == 0) return pcol0;
    const int pn = pcol0 >> 8, w = pcol0 & 255, bj = w >> 7, q = (w >> 5) & 3;
    if (mode == 1) return pn < 8 ? pn * 256 + q * 64 + bj * 32
                               : (bj ? 2560 : 2048) + (pn - 8) * 128 + q * 32;
    return bj * DFF + pn * 128 + q * 32;
}
__device__ __forceinline__ void transpose_item(const float* W, int K, int N, bf16* WT, int row_off, const float* gain, int mode, int item, int lane, float scale = 1.0f) {
    const int nblk = N / 32, kb = item / nblk, nb = item % nblk, k0 = 64 * kb, n0 = 32 * nb, ln0 = map_col(mode, n0);
    const int q = lane & 7, c = lane >> 3;
    f32x4 w[8];
#pragma unroll
    for (int i = 0; i < 8; ++i) w[i] = *(const f32x4*)(W + (size_t)(k0 + 8 * c + i) * N + ln0 + 4 * q);
    if (gain) { const f32x4 g0 = *(const f32x4*)(gain + k0 + 8 * c) * scale, g1 = *(const f32x4*)(gain + k0 + 8 * c + 4) * scale;
#pragma unroll
        for (int i = 0; i < 4; ++i) { w[i] = w[i] * g0[i]; w[4 + i] = w[4 + i] * g1[i]; } }
#pragma unroll
    for (int j = 0; j < 4; ++j) {
        u32x4 o; o.x = cvt_pk_bf16(w[0][j], w[1][j]); o.y = cvt_pk_bf16(w[2][j], w[3][j]); o.z = cvt_pk_bf16(w[4][j], w[5][j]); o.w = cvt_pk_bf16(w[6][j], w[7][j]);
        *(u32x4*)(WT + (size_t)(row_off + n0 + 4 * q + j) * K + k0 + 8 * c) = o; }
}

__device__ const float INV_REV[256] = {
  0.15915493667125702f, 6.4206382432985265e-09f,
  0.14810514450073242f, -4.283657428771903e-09f,
  0.13782250881195068f, -6.20796791750422e-09f,
  0.128253772854805f, -5.320577756151579e-09f,
  0.11934936791658401f, 2.2946649025357146e-09f,
  0.11106318980455399f, -2.783397956562794e-09f,
  0.10335229337215424f, 3.246279911550687e-09f,
  0.09617675840854645f, -8.095586423451095e-10f,
  0.08949939906597137f, 2.5429196526260966e-09f,
  0.08328563719987869f, 3.617293797830712e-09f,
  0.07750328630208969f, 2.453284464465355e-09f,
  0.07212239503860474f, -1.4427524730464825e-09f,
  0.06711508333683014f, -3.316028840405494e-10f,
  0.062455419450998306f, 3.183421859453972e-10f,
  0.0581192672252655f, 2.1661074323109375e-10f,
  0.0540841668844223f, -1.5636965056131658e-09f,
  0.050329212099313736f, 5.173299288951938e-12f,
  0.04683495685458183f, 7.718743977314091e-10f,
  0.043583303689956665f, -1.5846493006677065e-09f,
  0.04055740311741829f, -7.268268209514872e-10f,
  0.037741586565971375f, -1.848551645089458e-09f,
  0.035121262073516846f, 1.4448936491717745e-09f,
  0.032682865858078f, 1.4278992051253159e-11f,
  0.030413761734962463f, -5.366916355775686e-10f,
  0.02830219641327858f, -5.826552018639575e-10f,
  0.026337232440710068f, -3.038148344014502e-10f,
  0.02450869232416153f, -4.6209167048338884e-10f,
  0.022807102650403976f, 7.561994919136339e-10f,
  0.021223653107881546f, -3.431038786416707e-10f,
  0.019750138744711876f, -8.754094671381552e-10f,
  0.018378926441073418f, -3.35393740558132e-10f,
  0.017102913931012154f, 8.452463173824754e-10f,
  0.01591549441218376f, -1.0299423119919382e-10f,
  0.014810513705015182f, 3.16692339019653e-10f,
  0.013782250694930553f, -4.345322712762112e-10f,
  0.012825376354157925f, 3.992647878980904e-10f,
  0.011934936977922916f, 4.320196977936064e-11f,
  0.011106318794190884f, -9.207527795762616e-11f,
  0.010335229337215424f, 3.246279911550687e-10f,
  0.00961767602711916f, -2.672203847087218e-10f,
  0.008949940092861652f, 6.802745172729274e-11f,
  0.008328564465045929f, -3.833286743581965e-10f,
  0.007750329095870256f, -2.2033284918787643e-10f,
  0.007212239317595959f, 4.1989262761221724e-11f,
  0.006711508147418499f, 1.531042237434832e-10f,
  0.006245541851967573f, 1.249664816072027e-10f,
  0.005811926908791065f, -1.646034419877651e-10f,
  0.005408416502177715f, 2.9894860892332176e-11f,
  0.005032921209931374f, 5.173298855271069e-13f,
  0.004683495964854956f, -2.0220933261150265e-10f,
  0.004358330275863409f, -6.533267676855914e-11f,
  0.004055740311741829f, -7.268267931959116e-11f,
  0.003774158423766494f, 4.797548469603896e-11f,
  0.0035121263936161995f, -4.177515278147581e-11f,
  0.0032682865858078003f, 1.4278991400731855e-12f,
  0.0030413761269301176f, -7.103032138161547e-12f,
  0.0028302196878939867f, -1.0483165030494845e-10f,
  0.002633723197504878f, 1.6184645637573603e-11f,
  0.0024508691858500242f, 3.5696104275576013e-13f,
  0.0022807102650403976f, 7.561994780358461e-11f,
  0.0021223651710897684f, 1.0538799694037593e-10f,
  0.0019750138744711876f, -8.754094671381552e-11f,
  0.0018378925742581487f, 3.630981973423708e-11f,
  0.0017102914862334728f, -8.60762763149614e-12f,
  0.0015915494877845049f, -5.686555046291453e-11f,
  0.0014810514403507113f, -3.817995919419559e-11f,
  0.001378225046209991f, -2.017016241528946e-11f,
  0.0012825377052649856f, -2.992271361246246e-11f,
  0.001193493721075356f, -1.8962867734395594e-11f,
  0.001110631856136024f, 1.4075536743096695e-11f,
  0.0010335230035707355f, -3.738639606232219e-11f,
  0.0009617675677873194f, 8.202558424152961e-12f,
  0.0008949940092861652f, 6.802744999256927e-12f,
  0.0008328563999384642f, 8.233260427592537e-12f,
  0.0007750329095870256f, -2.2033284918787643e-11f,
  0.000721223943401128f, -7.442605559626614e-12f,
  0.0006711508031003177f, 2.6951954557041802e-11f,
  0.0006245541735552251f, 2.4138179302579665e-11f,
  0.0005811926675960422f, 6.8227203400827996e-12f,
  0.0005408416618593037f, -8.652046093460264e-12f,
  0.0005032921326346695f, -1.1589799432665249e-11f,
  0.0004683495790231973f, -2.758635117214303e-12f,
  0.000435833033407107f, -1.2354033594730307e-11f,
  0.0004055740137118846f, 1.0194030515553454e-11f,
  0.00037741585401818156f, -6.843983713089585e-12f,
  0.00035121262772008777f, 7.464016384128858e-12f,
  0.00032682865276001394f, 5.9635560378801244e-12f,
  0.00030413761851377785f, -6.531069088322461e-12f,
  0.0002830219455063343f, 1.2799900028781508e-11f,
  0.0002633723197504878f, 1.6184644770211865e-12f,
  0.00024508690694347024f, 1.1677228628492742e-11f,
  0.00022807103232480586f, 1.7412285805915029e-12f,
  0.00021223652584012598f, 1.8076506003855686e-12f,
  0.00019750137289520353f, 5.7978205569853e-12f,
  0.00018378926324658096f, -2.189784378131554e-12f,
  0.00017102915444411337f, -6.681529027968702e-12f,
  0.0001591549371369183f, 5.954976962929681e-12f,
  0.00014810514403507113f, -3.817995832683385e-12f,
  0.000137822498800233f, 3.803749849817795e-12f,
  0.00012825377052649856f, -2.9922715780866804e-12f,
  0.00011934937356272712f, -3.351478166171984e-12f,
  0.0001110631856136024f, 1.407553652625626e-12f,
  0.00010335229308111593f, 3.5373182247916413e-12f,
  9.617675823392347e-05f, -6.34935680421389e-13f,
  8.949940092861652e-05f, 6.802744673996275e-13f,
  8.32856385386549e-05f, 2.2785176523321127e-12f,
  7.750328950351104e-05f, -7.481370124101661e-13f,
  7.212239142972976e-05f, 2.166122533078796e-12f,
  6.711508467560634e-05f, -1.6703791128058754e-12f,
  6.24554231762886e-05f, -3.4069481177206873e-12f,
  5.81192689423915e-05f, -1.500515206878661e-12f,
  5.408416473073885e-05f, 5.899869351747022e-13f,
  5.032921035308391e-05f, 1.7514031674589758e-12f,
  4.683495717472397e-05f, 4.5173223885489056e-13f,
  4.358330261311494e-05f, -5.078076088967098e-13f,
  4.0557402826379985e-05f, -4.3578850380740497e-13f,
  3.7741585401818156e-05f, -6.84398392993002e-13f,
  3.5121262044413015e-05f, 1.4739974648833587e-12f,
  3.268286673119292e-05f, -8.588358973646293e-13f,
  3.0413761123782024e-05f, 7.448882954680033e-14f,
  2.8302196369622834e-05f, -5.389994548778143e-13f,
  2.633723124745302e-05f, 8.89442219962483e-13f,
  2.4508692149538547e-05f, -2.8746869793448704e-13f,
  2.2807103960076347e-05f, -5.534729033591923e-13f,
  2.1223651856416836e-05f, 9.083608431409429e-13f,
  1.9750137653318234e-05f, 2.1598415872632615e-13f,
  1.8378925233264454e-05f, 8.724152043143585e-13f,
  1.7102915080613457e-05f, -3.043550112456772e-13f
};

__device__ __forceinline__ void gn_stats_rows(int pm, int head, const float* gns, float* mr, int tid) {
    if (tid < 256) {
        const int row = pm * 256 + tid;
        const f32x4* sp = (const f32x4*)(gns + ((size_t)row * 4 + head) * 16);
        const f32x4 a = sp[0], b = sp[1], c = sp[2], d = sp[3];
        const float s1 = ((a[0] + a[2]) + (b[0] + b[2])) + ((c[0] + c[2]) + (d[0] + d[2])), s2 = ((a[1] + a[3]) + (b[1] + b[3])) + ((c[1] + c[3]) + (d[1] + d[3]));
        const float mu = s1 * (1.0f / 512.0f), var = s2 * (1.0f / 512.0f) - mu * mu;
        float* o = mr + ((size_t)head * M_TOK + row) * 2; o[0] = mu; o[1] = __builtin_amdgcn_rsqf(fmaxf(var, 0.f) + EPS);
    }
}
__device__ __forceinline__ void fixup_rows(int pm, const float* uf, const float* ul, const float* cw, bf16* hid, int tid) {
    if ((pm & 15) == 0) return;
    for (int ch = tid; ch < DFF; ch += 512) {
        const int colg = (ch >> 7) * 256 + (ch & 127), colv = colg + 128;
        const float* l0 = ul + ((size_t)(pm - 1) * 2 + 0) * NUP; const float* l1 = l0 + NUP;
        const float* f0 = uf + ((size_t)pm * 2 + 0) * NUP; const float* f1 = f0 + NUP;
        const float wg0 = cw[ch], wg1 = cw[NUP + ch], wg2 = cw[2 * NUP + ch], wv0 = cw[DFF + ch], wv1 = cw[NUP + DFF + ch], wv2 = cw[2 * NUP + DFF + ch];
        const float g0 = wg0 * l0[colg] + wg1 * l1[colg] + wg2 * f0[colg], v0 = wv0 * l0[colv] + wv1 * l1[colv] + wv2 * f0[colv];
        const float g1 = wg0 * l1[colg] + wg1 * f0[colg] + wg2 * f1[colg], v1 = wv0 * l1[colv] + wv1 * f0[colv] + wv2 * f1[colv];
        hid[(size_t)(pm * 256 + 0) * DFF + ch] = (bf16)(cvt_pk_bf16(silu_f(g0) * v0, 0.f) & 0xffffu);
        hid[(size_t)(pm * 256 + 1) * DFF + ch] = (bf16)(cvt_pk_bf16(silu_f(g1) * v1, 0.f) & 0xffffu);
    }
}

struct Args { const float* in[18]; float* out; unsigned char* ws; int pad0, pad1; };

__global__ void __launch_bounds__(NWAVES * 64, 2) trunk_fwd(Args args) {
    extern __shared__ __attribute__((aligned(16))) unsigned char lds_raw[];
    LAS unsigned char* lds = (LAS unsigned char*)lds_raw;
    volatile LAS unsigned* MISC = (volatile LAS unsigned*)(lds + MISC_OFF);
    const int tid0 = threadIdx.x, wave = __builtin_amdgcn_readfirstlane(tid0 >> 6);
    const int G = gridDim.x, bx = blockIdx.x;
    const int vcu = (G % 8 == 0) ? (bx % 8) * (G / 8) + bx / 8 : bx;
    typedef const Args __attribute__((address_space(4)))* cargs_t;
#define FRESH const int tid = TIDX(), lane = tid & 63; (void)lane; cargs_t A_ = (cargs_t)__builtin_amdgcn_kernarg_segment_ptr(); asm volatile("" : "+s"(A_)); unsigned char* const ws = A_->ws; (void)ws
#define INP(i) (A_->in[i])
#define WSF(off) ((float*)(ws + (off)))
#define WSB(off) ((bf16*)(ws + (off)))
#define HB(off, rb) ((bf16*)(ws + WS_R + (size_t)half * HALF_REGION + (off) - (size_t)half * pg8::MH * (rb)))
#define RA(off) ((bf16*)(ws + WS_R + (off)))
#define HDB(rb) ((size_t)HALF_REGION - (size_t)pg8::MH * (rb))
    const size_t PSZ = (size_t)pg8::MH * 512;

    for (int u = tid0; u < (LDS_BYTES - MISC_OFF) / 4; u += NWAVES * 64) ((LAS unsigned*)(lds + MISC_OFF))[u] = 0u;
    __syncthreads();
    const Events ev = events_post((unsigned*)(args.ws + WS_CTL), MISC + 8);
    const int gw = vcu * NWAVES + wave, NGW = G * NWAVES;
#define EV(k, h) (2 * (k) + (h))
#define ENTER(k)
#define LEAVE(k) ev_step(ev, EV(k, half), half == 0 ? ((k) > 0 ? EV((k) - 1, 1) : -1) : EV(k, 0))

#pragma unroll 1
    for (int half = 0; half < 2; ++half) {
        FRESH;
        {
            constexpr int I_IN = 16 * 96, I_OUT = 16 * 32, I_Q = 16 * 32, I_V = 16 * 64, I_O = 32 * 32, I_UP = 16 * 176, I_DN = 44 * 32;
            constexpr int NITEMS = I_IN + I_OUT + 2 * I_Q + 2 * I_V + I_O + 2 * I_UP + 2 * I_DN;
            for (int it = (half == 0 ? 0 : I_IN) + gw; it < (half == 0 ? I_IN : NITEMS); it += NGW) {
                int r = it;
                if (r < I_IN) { transpose_item(INP(2), 1024, 3072, WSB(WS_WIN), 0, INP(1), 1, r, lane); continue; } r -= I_IN;
                if (r < I_OUT) { transpose_item(INP(6), 1024, 1024, WSB(WS_WOUT), 0, nullptr, 0, r, lane); continue; } r -= I_OUT;
                if (r < I_Q) { transpose_item(INP(8), 1024, 1024, WSB(WS_WQKV), 0, INP(7), 0, r, lane); continue; } r -= I_Q;
                if (r < I_Q) { transpose_item(INP(9), 1024, 1024, WSB(WS_WQKV), 1024, INP(7), 0, r, lane, 0.0625f); continue; } r -= I_Q;
                if (r < I_V) { transpose_item(INP(10), 1024, 2048, WSB(WS_WQKV), 2048, INP(7), 0, r, lane); continue; } r -= I_V;
                if (r < I_V) { transpose_item(INP(11), 1024, 2048, WSB(WS_WG), 0, INP(7), 0, r, lane); continue; } r -= I_V;
                if (r < I_O) { transpose_item(INP(13), 2048, 1024, WSB(WS_WO), 0, nullptr, 0, r, lane); continue; } r -= I_O;
                if (r < I_UP) { transpose_item(INP(15), 1024, NUP, WSB(WS_UP0), 0, INP(14), 2, r, lane); continue; } r -= I_UP;
                if (r < I_UP) { transpose_item(INP(15) + (size_t)1024 * NUP, 1024, NUP, WSB(WS_UP1), 0, INP(14) + 1024, 2, r, lane); continue; } r -= I_UP;
                if (r < I_DN) { transpose_item(INP(17), DFF, 1024, WSB(WS_DN0), 0, nullptr, 0, r, lane); continue; } r -= I_DN;
                transpose_item(INP(17) + (size_t)DFF * 1024, DFF, 1024, WSB(WS_DN1), 0, nullptr, 0, r, lane);
            }
            float* COS = WSF(WS_COS); float* SIN = WSF(WS_SIN);
            if (half == 1) for (int i = vcu * 512 + tid; i < SEQ * 128; i += G * 512) {
                const int pos = i >> 7, k = i & 127; const float irx = INV_REV[2 * k], iry = INV_REV[2 * k + 1]; const float fp = (float)pos;
                const float ph = fp * irx, pe = __builtin_fmaf(fp, irx, -ph) + fp * iry;
                const float rev = (ph - __builtin_floorf(ph)) + pe;
                COS[i] = __builtin_amdgcn_cosf(rev); SIN[i] = __builtin_amdgcn_sinf(rev);
            }
        }
        { const float* x = INP(0); bf16* XB = WSB(WS_XB); float* SSQ = WSF(WS_SSQ);
        for (int m = half * pg8::MH + 4 * gw; m < (half + 1) * pg8::MH; m += 4 * NGW) {
            const f32x4* xr = (const f32x4*)(x + (size_t)m * DM) + lane; float sq[4] = {0.f, 0.f, 0.f, 0.f};
            unsigned long long* o8 = (unsigned long long*)(XB + (size_t)m * DM) + lane;
            f32x4 v[16];
#pragma unroll
            for (int j = 0; j < 16; ++j) v[j] = xr[64 * j];
#pragma unroll
            for (int j = 0; j < 16; ++j) { sq[j >> 2] += (v[j][0] * v[j][0] + v[j][1] * v[j][1]) + (v[j][2] * v[j][2] + v[j][3] * v[j][3]);
                o8[64 * j] = (unsigned long long)cvt_pk_bf16(v[j][0], v[j][1]) | ((unsigned long long)cvt_pk_bf16(v[j][2], v[j][3]) << 32); }
#pragma unroll
            for (int r = 0; r < 4; ++r) sq[r] = wave_sum(sq[r]);
            if (lane < 16) SSQ[(size_t)m * 4 + lane] = (lane == 0) ? sq[0] : (lane == 4) ? sq[1] : (lane == 8) ? sq[2] : (lane == 12) ? sq[3] : 0.f;
        } }
        LEAVE(0);
    }
    {
        FRESH;
        pg8::Gemm g{WSB(WS_XB), WSB(WS_WIN), M_TOK, 3072, 1024}; PairOrder S; S.init(3072, G, bx, 0, ev, EV(1, 0), EV(0, 1));
        pg8::EpiProj E{RA(RO_PROJ), HDB(1024) / 2, WSF(WS_SSQ), INP(3), INP(4), (LAS float*)(lds + XCH_OFF)};
        pg8::gemm_phase<pg8::EpiProj, PairOrder, true, true>(lds + RING_OFF, g, S, E);
        if (S.nA == 0) ev_step(ev, EV(1, 0), -1);
        ev_step(ev, EV(1, 1), EV(1, 0));
    }
#pragma unroll 1
    for (int half = 0; half < 2; ++half) {
        ENTER(2); FRESH;
        bf16* PROJ = HB(RO_PROJ, 1024); bf16* OP = HB(RO_OP, 1024); float* LSE = WSF(WS_LSE);
        const int per = (3 * 1024 + G - 1) / G; int n = 3 * 1024 - vcu * per; n = n < 0 ? 0 : (n > per ? per : n);
        att::attn_units(lds + RING_OFF, PROJ, PROJ + PSZ, PROJ + 2 * PSZ, OP, LSE, vcu * per, n, half);
        LEAVE(2);
    }
#pragma unroll 1
    for (int half = 0; half < 2; ++half) {
        ENTER(3); FRESH;
        bf16* PROJ = HB(RO_PROJ, 1024);
        merge_sconv_phase(bx * 512 + tid, G * 512, HB(RO_OP, 1024), WSF(WS_LSE), PROJ + 3 * PSZ, PROJ + 4 * PSZ, INP(5), HB(RO_AB, 2048), half);
        LEAVE(3);
    }
    {
        FRESH;
        pg8::Gemm g{RA(RO_AB), WSB(WS_WOUT), M_TOK, 1024, 1024}; PairOrder S; S.init(1024, G, bx, HDB(2048), ev, EV(4, 0), EV(3, 1));
        pg8::EpiRes<false> E{A_->out, WSB(WS_XB), WSF(WS_SSQ), (LAS float*)(lds + XCH_OFF)};
        pg8::gemm_phase<pg8::EpiRes<false>, PairOrder, true, true>(lds + RING_OFF, g, S, E);
        if (S.nA == 0) ev_step(ev, EV(4, 0), -1);
        ev_step(ev, EV(4, 1), EV(4, 0));
    }
#define FFN_UP(pu, l) \
    { \
        FRESH; \
        pg8::Gemm g{WSB(WS_XB), WSB((l) ? WS_UP1 : WS_UP0), M_TOK, NUP, 1024}; PairOrder S; S.init(NUP, G, bx, 0, ev, EV(pu, 0), EV((pu) - 1, 1)); \
        pg8::EpiUp E{RA(RO_HID), HDB(2 * DFF) / 2, WSF(WS_SSQ), INP(16) + (size_t)(l) * 3 * NUP, WSF(WS_UF), WSF(WS_UL), (LAS float*)(lds + XCH_OFF)}; \
        pg8::gemm_phase<pg8::EpiUp, PairOrder, true, true>(lds + RING_OFF, g, S, E); \
        if (S.nA == 0) ev_step(ev, EV(pu, 0), -1); \
        ev_step(ev, EV(pu, 1), EV(pu, 0)); \
    }
#define FFN_DOWN(pd, l, LASTF) \
    _Pragma("unroll 1") for (int half = 0; half < 2; ++half) { \
        ENTER(pd); FRESH; \
        pg8::Gemm g{HB(RO_HID, 2 * DFF), WSB((l) ? WS_DN1 : WS_DN0), M_TOK, 1024, DFF}; pg8::HalfOrder S; S.init(1024, G, bx, half); \
        { const int en_ = (LASTF) ? (half == 0 ? EV((pd) - 1, 1) : -1) : (half == 0 ? EV((pd) - 1, 1) : EV(pd, 0)); if (en_ >= 0) S.set_early((const unsigned*)(ws + WS_CTL) + EV_DONE(en_), MISC + 13, (unsigned)(en_ + 1)); } \
        { pg8::Unit u; for (int i = 0; S.next(i, u); ++i) fixup_rows(u.pm, WSF(WS_UF), WSF(WS_UL), INP(16) + (size_t)(l) * 3 * NUP, HB(RO_HID, 2 * DFF), tid); } \
        VM_WAIT(); __syncthreads(); \
        pg8::EpiRes<LASTF> E{A_->out, WSB(WS_XB), WSF(WS_SSQ), (LAS float*)(lds + XCH_OFF)}; \
        pg8::gemm_phase<pg8::EpiRes<LASTF>, pg8::HalfOrder, true, true>(lds + RING_OFF, g, S, E); \
        if (!(LASTF)) LEAVE(pd); else if (half == 0) ev_step(ev, -1, EV((pd) - 1, 1)); \
    }
    FFN_UP(5, 0)
    FFN_DOWN(6, 0, false)
    {
        FRESH;
        pg8::Gemm g{WSB(WS_XB), WSB(WS_WQKV), M_TOK, 4096, 1024}; PairOrder S; S.init(4096, G, bx, 0, ev, EV(7, 0), EV(6, 1));
        pg8::EpiQKV E{RA(RO_Q1), RA(RO_K1), RA(RO_V1), HDB(2048) / 2, HDB(4096) / 2, WSF(WS_SSQ), WSF(WS_COS), WSF(WS_SIN), (LAS float*)(lds + XCH_OFF)};
        pg8::gemm_phase<pg8::EpiQKV, PairOrder, true, true>(lds + RING_OFF, g, S, E);
        if (S.nA == 0) ev_step(ev, EV(7, 0), -1);
        ev_step(ev, EV(7, 1), EV(7, 0));
    }
#pragma unroll 1
    for (int half = 0; half < 2; ++half) {
        ENTER(8); FRESH;
        bf16* PS = (bf16*)(ws + WS_R + (size_t)half * HALF_REGION + RO_PS) - (size_t)half * 512 * 16384;
        for (int pr = half * 256 + vcu; pr < (half + 1) * 256; pr += G) ret::score_pair(lds + RING_OFF, HB(RO_Q1, 2048), HB(RO_K1, 2048), PS, pr);
        bool mine0 = false; for (int it = vcu; it < 256; it += G) mine0 |= (it >> 7) == 0;
        ev_step(ev, EV(8, half), half == 0 ? EV(7, 1) : (mine0 ? EV(8, 0) : -1));
    }
#pragma unroll 1
    for (int half = 0; half < 2; ++half) {
        for (int it = vcu; it < 256; it += G) {
            if ((it >> 7) != half) continue;
            FRESH;
            bf16* PS = (bf16*)(ws + WS_R + (size_t)half * HALF_REGION + RO_PS) - (size_t)half * 512 * 16384;
            ret::ret_item(lds + RING_OFF, HB(RO_Q1, 2048), HB(RO_K1, 2048), HB(RO_V1, 4096), PS, WSF(WS_GNS), it);
        }
        bool mine1 = false; for (int it = vcu; it < 256; it += G) mine1 |= (it >> 7) == 1;
        ev_step(ev, EV(9, half), half == 0 ? (mine1 ? EV(8, 1) : -1) : EV(9, 0));
    }
#pragma unroll 1
    for (int half = 0; half < 2; ++half) {
        ENTER(10); FRESH;
        pg8::Gemm g{WSB(WS_XB), WSB(WS_WG), M_TOK, 2048, 1024}; pg8::HalfOrder S; S.init(2048, G, bx, half);
        { const int en_ = half == 0 ? EV(9, 1) : EV(10, 0); S.set_early((const unsigned*)(ws + WS_CTL) + EV_DONE(en_), MISC + 13, (unsigned)(en_ + 1)); }
        { pg8::Unit u; for (int i = 0; S.next(i, u); ++i) gn_stats_rows(u.pm, u.pn >> 1, WSF(WS_GNS), WSF(WS_MR), tid); }
        VM_WAIT(); __syncthreads();
        pg8::EpiGate E{HB(RO_V1, 4096), WSF(WS_SSQ), WSF(WS_MR), INP(12), (LAS float*)(lds + XCH_OFF)};
        pg8::gemm_phase<pg8::EpiGate, pg8::HalfOrder, true, true>(lds + RING_OFF, g, S, E);
        LEAVE(10);
    }
    {
        FRESH;
        pg8::Gemm g{RA(RO_V1), WSB(WS_WO), M_TOK, 1024, 2048}; PairOrder S; S.init(1024, G, bx, HDB(4096), ev, EV(11, 0), EV(10, 1));
        pg8::EpiRes<false> E{A_->out, WSB(WS_XB), WSF(WS_SSQ), (LAS float*)(lds + XCH_OFF)};
        pg8::gemm_phase<pg8::EpiRes<false>, PairOrder, true, true>(lds + RING_OFF, g, S, E);
        if (S.nA == 0) ev_step(ev, EV(11, 0), -1);
        ev_step(ev, EV(11, 1), EV(11, 0));
    }
    FFN_UP(12, 1)
    FFN_DOWN(13, 1, true)
#undef FFN_UP
#undef FFN_DOWN
#undef FRESH
#undef INP
#undef WSF
#undef WSB
#undef HB
#undef RA
#undef HDB
#undef EV
#undef ENTER
#undef LEAVE
}

extern "C" void kernel_launch(void* const* d_in, const int* in_sizes, int n_in, void* d_out, int out_size, void* d_ws, size_t ws_size, hipStream_t stream) {
    static int grid = 0;
    if (grid == 0) {
        if (n_in != 18 || in_sizes[0] != M_TOK * DM || out_size != M_TOK * DM || ws_size < WS_END) {
            fprintf(stderr, "kernel_launch: unexpected problem (n_in %d, in0 %d, out %d, ws %zu, need %zu)\n", n_in, n_in > 0 ? in_sizes[0] : -1, out_size, ws_size, (size_t)WS_END); grid = -1; return; }
        int dev = 0, cus = 0, per_cu = 0;
        if (hipGetDevice(&dev) != hipSuccess || hipDeviceGetAttribute(&cus, hipDeviceAttributeMultiprocessorCount, dev) != hipSuccess) { grid = -1; return; }
        if (hipFuncSetAttribute((const void*)trunk_fwd, hipFuncAttributeMaxDynamicSharedMemorySize, LDS_BYTES) != hipSuccess) { fprintf(stderr, "kernel_launch: hipFuncSetAttribute failed\n"); grid = -1; return; }
        if (hipOccupancyMaxActiveBlocksPerMultiprocessor(&per_cu, (const void*)trunk_fwd, NWAVES * 64, LDS_BYTES) != hipSuccess || per_cu < 1) { fprintf(stderr, "kernel_launch: occupancy query says %d\n", per_cu); grid = -1; (void)hipGetLastError(); return; }
        grid = cus * (per_cu < 1 ? per_cu : 1);
    }
    if (grid < 0) return;
    (void)hipMemsetAsync((char*)d_ws + WS_CTL, 0, CTL_ZERO_BYTES, stream);
    Args a{};
    for (int i = 0; i < 18; ++i) a.in[i] = (const float*)d_in[i];
    a.out = (float*)d_out; a.ws = (unsigned char*)d_ws;
    void* kargs[] = {&a};
    hipError_t e = hipLaunchCooperativeKernel((const void*)trunk_fwd, dim3(grid), dim3(NWAVES * 64), kargs, LDS_BYTES, stream);
    if (e != hipSuccess) fprintf(stderr, "kernel_launch: cooperative launch failed: %s (grid %d)\n", hipGetErrorString(e), grid);
}
```
